# Optimizing an MI355X kernel written in HIP

```python
import math
import jax, jax.numpy as jnp
from jax import lax
import numpy as np

D_MODEL = 1024
BATCH = 8
SEQ = 4096
DEPTH = 4

N_A = DEPTH // 2
N_B = DEPTH - N_A
A_HEADS = 16
A_NOPE = 64
A_ROPE = 32
A_VDIM = 64
A_QLORA = D_MODEL // 4
A_KVLORA = D_MODEL // 8
A_WIDTH = A_HEADS * A_VDIM
A_IN = A_QLORA + A_KVLORA + A_ROPE + A_WIDTH
ROPE_THETA = 10000.0
B_HEADS = 16
B_DIM = 64
B_WIDTH = B_HEADS * B_DIM
QB = 128
EPS = 1e-6

kernel_name = 'yoco_mla_stickbreaking_hybrid'


def rmsnorm(x, g):
    xf = x.astype(jnp.float32)
    y = xf * lax.rsqrt(jnp.mean(xf * xf, axis=-1, keepdims=True) + EPS)
    return (y * g.astype(jnp.float32)).astype(x.dtype)


def rope_tables(S):
    pos = jnp.arange(S, dtype=jnp.float32)
    inv = 1.0 / (ROPE_THETA ** (jnp.arange(0, A_ROPE, 2, dtype=jnp.float32) / A_ROPE))
    ang = pos[:, None] * inv[None, :]
    return jnp.cos(ang), jnp.sin(ang)


def apply_rope(t, cos, sin):
    half = t.shape[-1] // 2
    t1, t2 = t[..., :half], t[..., half:]
    cos = cos.astype(t.dtype)
    sin = sin.astype(t.dtype)
    return jnp.concatenate([t1 * cos - t2 * sin, t1 * sin + t2 * cos], axis=-1)


def to_blocks(t):
    B, S, H, d = t.shape
    return t.reshape(B, S // QB, QB, H, d).transpose(1, 0, 3, 2, 4)


def from_blocks(o):
    nb, B, H, q, d = o.shape
    return o.transpose(1, 0, 3, 2, 4).reshape(B, nb * q, H * d)


def mla_attention(q_nope, q_rope, k_nope, k_rope, v):
    S = q_nope.shape[1]
    kpos = jnp.arange(S)
    kn = k_nope.transpose(0, 2, 1, 3)
    vv = v.transpose(0, 2, 1, 3)
    scale = 1.0 / math.sqrt(A_NOPE + A_ROPE)

    def block(args):
        qn, qr, blk = args
        qpos = blk * QB + jnp.arange(QB)
        s = (jnp.einsum('bhqd,bhkd->bhqk', qn, kn)
             + jnp.einsum('bhqr,bkr->bhqk', qr, k_rope)).astype(jnp.float32) * scale
        s = jnp.where(kpos[None, :] <= qpos[:, None], s, -jnp.inf)
        p = jax.nn.softmax(s, axis=-1)
        return jnp.einsum('bhqk,bhkd->bhqd', p.astype(vv.dtype), vv)

    o = lax.map(block, (to_blocks(q_nope), to_blocks(q_rope), jnp.arange(S // QB)))
    return from_blocks(o)


def stick_breaking_attention(q, k, v):
    S = q.shape[1]
    kpos = jnp.arange(S)
    scale = 1.0 / math.sqrt(B_DIM)

    def block(args):
        qb, blk = args
        qpos = blk * QB + jnp.arange(QB)
        mask = kpos[None, :] < qpos[:, None]
        z = jnp.einsum('bhqd,bhkd->bhqk', qb, k).astype(jnp.float32) * scale
        log_rest = jnp.where(mask, jax.nn.log_sigmoid(-z), 0.0)
        after = lax.cumsum(log_rest, axis=3, reverse=True) - log_rest
        a = jnp.where(mask, jnp.exp(jax.nn.log_sigmoid(z) + after), 0.0)
        return jnp.einsum('bhqk,bhkd->bhqd', a.astype(v.dtype), v)

    o = lax.map(block, (to_blocks(q), jnp.arange(S // QB)))
    return from_blocks(o)


def mla_mixer(h, w_in, q_norm, w_uq, kv_norm, w_ukv, cos, sin):
    B, S, _ = h.shape
    proj = h @ w_in
    c_q, c_kv, k_r, gate = jnp.split(
        proj, [A_QLORA, A_QLORA + A_KVLORA, A_QLORA + A_KVLORA + A_ROPE], axis=-1)
    q = (rmsnorm(c_q, q_norm) @ w_uq).reshape(B, S, A_HEADS, A_NOPE + A_ROPE)
    q_nope = q[..., :A_NOPE]
    q_rope = apply_rope(q[..., A_NOPE:], cos[:, None, :], sin[:, None, :])
    kv = (rmsnorm(c_kv, kv_norm) @ w_ukv).reshape(B, S, A_HEADS, A_NOPE + A_VDIM)
    k_nope, v = kv[..., :A_NOPE], kv[..., A_NOPE:]
    k_rope = apply_rope(k_r, cos, sin)
    o = mla_attention(q_nope, q_rope, k_nope, k_rope, v)
    return o * jax.nn.silu(gate)


def sb_mixer(h, w_in, k, v):
    B, S, _ = h.shape
    q, gate = jnp.split(h @ w_in, [B_WIDTH], axis=-1)
    o = stick_breaking_attention(q.reshape(B, S, B_HEADS, B_DIM), k, v)
    return o * jax.nn.silu(gate)


def setup_inputs(seed: int = 0) -> dict:
    key = jax.random.key(seed)
    ks = jax.random.split(key, 20)

    def w(k, shape, fan_in):
        return jax.random.normal(k, shape, jnp.float32) * fan_in ** -0.5

    def gain(k, shape):
        return 1.0 + 0.1 * jax.random.normal(k, shape, jnp.float32)

    return {
        'x': jax.random.normal(ks[0], (BATCH, SEQ, D_MODEL), jnp.float32),
        'a_norm_pre': gain(ks[1], (N_A, D_MODEL)),
        'a_w_in': w(ks[2], (N_A, D_MODEL, A_IN), D_MODEL),
        'a_q_norm': gain(ks[3], (N_A, A_QLORA)),
        'a_w_uq': w(ks[4], (N_A, A_QLORA, A_HEADS * (A_NOPE + A_ROPE)), A_QLORA),
        'a_kv_norm': gain(ks[5], (N_A, A_KVLORA)),
        'a_w_ukv': w(ks[6], (N_A, A_KVLORA, A_HEADS * (A_NOPE + A_VDIM)), A_KVLORA),
        'a_w_o': w(ks[7], (N_A, A_WIDTH, D_MODEL), A_WIDTH),
        'a_norm_post': gain(ks[8], (N_A, D_MODEL)),
        'b_kv_norm': gain(ks[9], (D_MODEL,)),
        'b_w_kv': w(ks[10], (D_MODEL, 2 * B_WIDTH), D_MODEL),
        'b_norm_pre': gain(ks[11], (N_B, D_MODEL)),
        'b_w_in': w(ks[12], (N_B, D_MODEL, 2 * B_WIDTH), D_MODEL),
        'b_w_o': w(ks[13], (N_B, B_WIDTH, D_MODEL), B_WIDTH),
        'b_norm_post': gain(ks[14], (N_B, D_MODEL)),
    }


def reference(x, a_norm_pre, a_w_in, a_q_norm, a_w_uq, a_kv_norm, a_w_ukv, a_w_o,
              a_norm_post, b_kv_norm, b_w_kv, b_norm_pre, b_w_in, b_w_o, b_norm_post):
    B, S, _ = x.shape
    cos, sin = rope_tables(S)
    k_shared = None
    v_shared = None
    for layer in range(DEPTH):
        if layer < N_A:
            i = layer
            h = rmsnorm(x, a_norm_pre[i])
            out = mla_mixer(h, a_w_in[i], a_q_norm[i], a_w_uq[i], a_kv_norm[i],
                            a_w_ukv[i], cos, sin) @ a_w_o[i]
            x = x + rmsnorm(out, a_norm_post[i])
        else:
            j = layer - N_A
            if j == 0:
                kv = rmsnorm(x, b_kv_norm) @ b_w_kv
                k_s, v_s = jnp.split(kv, [B_WIDTH], axis=-1)
                k_shared = k_s.reshape(B, S, B_HEADS, B_DIM).transpose(0, 2, 1, 3)
                v_shared = v_s.reshape(B, S, B_HEADS, B_DIM).transpose(0, 2, 1, 3)
            h = rmsnorm(x, b_norm_pre[j])
            out = sb_mixer(h, b_w_in[j], k_shared, v_shared) @ b_w_o[j]
            x = x + rmsnorm(out, b_norm_post[j])
    return x
```

```cpp
#include <hip/hip_runtime.h>
#include <hip/hip_cooperative_groups.h>
#include <cstdio>
#include <cstdint>
namespace cg = cooperative_groups;

#ifndef ONE_LAUNCH
#define ONE_LAUNCH 0
#endif

typedef unsigned short bf16_t;
typedef short bf16x8 __attribute__((ext_vector_type(8)));
typedef short s16x4 __attribute__((ext_vector_type(4)));
typedef float f32x4 __attribute__((ext_vector_type(4)));
typedef float f32x16 __attribute__((ext_vector_type(16)));
typedef unsigned u32x4 __attribute__((ext_vector_type(4)));
typedef unsigned u32x2 __attribute__((ext_vector_type(2)));

#define DI __device__ __forceinline__
#define NTOK 32768
#define SEQL 4096
#define EPSV 1e-6f
#define NPHASE 19
#define LOG2E 1.4426950408889634f
#define QSCALE_A (0.10206207261596577f * LOG2E)
#define QSCALE_B (0.125f * LOG2E)
#define SB_DONE_THR (-160.0f)

struct Params {
  const float* x; const float* a_norm_pre; const float* a_w_in; const float* a_q_norm; const float* a_w_uq;
  const float* a_kv_norm; const float* a_w_ukv; const float* a_w_o; const float* a_norm_post;
  const float* b_kv_norm; const float* b_w_kv; const float* b_norm_pre; const float* b_w_in; const float* b_w_o; const float* b_norm_post;
  float* out;
  bf16_t* wt_a_in; bf16_t* wt_a_uq; bf16_t* wt_a_ukv; bf16_t* wt_a_o; bf16_t* wt_b1; bf16_t* wt_b_o;
  bf16_t* xb;
  bf16_t* cq; bf16_t* ckv;
  bf16_t* gate;
  bf16_t* Q; bf16_t* Kb; bf16_t* Vt;
  float* rs_x; float* ssq_cq; float* ssq_ckv; float* ssq_out; float2* rope; unsigned* counters;
};

typedef float f32x2 __attribute__((ext_vector_type(2)));
typedef __bf16 bf16x2n __attribute__((ext_vector_type(2)));
DI unsigned pk_bf16(float lo, float hi) { f32x2 v; v.x = lo; v.y = hi; return __builtin_bit_cast(unsigned, __builtin_convertvector(v, bf16x2n)); }
DI int get_tid() { int t = threadIdx.x; asm volatile("" : "+v"(t)); return t; }
DI float bf_lo(unsigned u) { return __uint_as_float(u << 16); }
DI float bf_hi(unsigned u) { return __uint_as_float(u & 0xffff0000u); }
DI float wave_sum(float v) {
#pragma unroll
  for (int o = 32; o > 0; o >>= 1) v += __shfl_xor(v, o);
  return v;
}
DI float silu_f(float v) { return v * __builtin_amdgcn_rcpf(1.0f + __builtin_amdgcn_exp2f(-v * LOG2E)); }
DI u32x2 pack4(f32x4 v) { u32x2 w; w.x = pk_bf16(v[0], v[1]); w.y = pk_bf16(v[2], v[3]); return w; }

DI void conv_phase(const Params& p, char* lds) {
  float (*tile)[65] = (float (*)[65])lds;
  const int tid = get_tid();
  for (int t = blockIdx.x; t < 3648; t += gridDim.x) {
    const float* src; const float* gain; bf16_t* dst; int K, Nsrc, map = 0; int tt = t; int i;
    if (tt < 768) { i = tt / 384; tt %= 384; src = p.a_w_in + (size_t)i * 1024 * 1440; gain = p.a_norm_pre + i * 1024; dst = p.wt_a_in + (size_t)i * 1536 * 1024; K = 1024; Nsrc = 1440; map = 1; }
    else if ((tt -= 768) < 192) { i = tt / 96; tt %= 96; src = p.a_w_uq + (size_t)i * 256 * 1536; gain = p.a_q_norm + i * 256; dst = p.wt_a_uq + (size_t)i * 1536 * 256; K = 256; Nsrc = 1536; }
    else if ((tt -= 192) < 128) { i = tt / 64; tt %= 64; src = p.a_w_ukv + (size_t)i * 128 * 2048; gain = p.a_kv_norm + i * 128; dst = p.wt_a_ukv + (size_t)i * 2048 * 128; K = 128; Nsrc = 2048; }
    else if ((tt -= 128) < 512) { i = tt / 256; tt %= 256; src = p.a_w_o + (size_t)i * 1024 * 1024; gain = nullptr; dst = p.wt_a_o + (size_t)i * 1024 * 1024; K = 1024; Nsrc = 1024; }
    else if ((tt -= 512) < 512) { src = p.b_w_kv; gain = p.b_kv_norm; dst = p.wt_b1; K = 1024; Nsrc = 2048; }
    else if ((tt -= 512) < 1024) { i = tt / 512; tt %= 512; src = p.b_w_in + (size_t)i * 1024 * 2048; gain = p.b_norm_pre + i * 1024; dst = p.wt_b1 + (size_t)(1 + i) * 2048 * 1024; K = 1024; Nsrc = 2048; }
    else { tt -= 1024; i = tt / 256; tt %= 256; src = p.b_w_o + (size_t)i * 1024 * 1024; gain = nullptr; dst = p.wt_b_o + (size_t)i * 1024 * 1024; K = 1024; Nsrc = 1024; }
    const int nkt = K >> 6; const int tn = tt / nkt, tk = tt % nkt; const int n0 = tn * 64, k0 = tk * 64;
    {
      const int nn = tid & 63, n = n0 + nn; int sc = n;
      if (map == 1) sc = n < 384 ? n : (n < 1408 ? n + 32 : (n < 1440 ? n - 1408 + 384 : -1));
#pragma unroll 4
      for (int r = 0; r < 16; ++r) {
        const int kk = (tid >> 6) + 4 * r; float v = 0.f;
        if (sc >= 0) { v = src[(size_t)(k0 + kk) * Nsrc + sc]; if (gain) v *= gain[k0 + kk]; }
        tile[kk][nn] = v;
      }
    }
    __syncthreads();
    {
      const int nn = tid >> 2, kc = (tid & 3) * 16;
      u32x4 w0, w1;
      w0.x = pk_bf16(tile[kc + 0][nn], tile[kc + 1][nn]); w0.y = pk_bf16(tile[kc + 2][nn], tile[kc + 3][nn]);
      w0.z = pk_bf16(tile[kc + 4][nn], tile[kc + 5][nn]); w0.w = pk_bf16(tile[kc + 6][nn], tile[kc + 7][nn]);
      w1.x = pk_bf16(tile[kc + 8][nn], tile[kc + 9][nn]); w1.y = pk_bf16(tile[kc + 10][nn], tile[kc + 11][nn]);
      w1.z = pk_bf16(tile[kc + 12][nn], tile[kc + 13][nn]); w1.w = pk_bf16(tile[kc + 14][nn], tile[kc + 15][nn]);
      bf16_t* d = dst + (size_t)(n0 + nn) * K + k0 + kc;
      *(u32x4*)d = w0; *(u32x4*)(d + 8) = w1;
    }
    __syncthreads();
  }
}

DI void rope_phase(const Params& p) {
  for (int e = blockIdx.x * 256 + get_tid(); e < SEQL * 16; e += gridDim.x * 256) {
    const int pos = e >> 4, i = e & 15;
    const double bs = (i & 3) == 0 ? 1.0 : (i & 3) == 1 ? 0.56234132519034907 : (i & 3) == 2 ? 0.31622776601683794 : 0.17782794100389228;
    const double sc = (i >> 2) == 0 ? 1.0 : (i >> 2) == 1 ? 0.1 : (i >> 2) == 2 ? 0.01 : 0.001;
    const float inv = (float)(bs * sc);
    const float angf = (float)pos * inv;
    const double a = (double)angf;
    const double n = rint(a * 0.63661977236758134);
    double r = fma(-n, 1.5707963267948966, a); r = fma(-n, 6.123233995736766e-17, r);
    const double r2 = r * r;
    const double sp = r * (1.0 + r2 * (-1.0 / 6.0 + r2 * (1.0 / 120.0 + r2 * (-1.0 / 5040.0 + r2 * (1.0 / 362880.0 + r2 * (-1.0 / 39916800.0 + r2 * (1.0 / 6227020800.0)))))));
    const double cp = 1.0 + r2 * (-0.5 + r2 * (1.0 / 24.0 + r2 * (-1.0 / 720.0 + r2 * (1.0 / 40320.0 + r2 * (-1.0 / 3628800.0 + r2 * (1.0 / 479001600.0 + r2 * (-1.0 / 87178291200.0)))))));
    const int q = ((int)n) & 3;
    const double c = q == 0 ? cp : q == 1 ? -sp : q == 2 ? -cp : sp;
    const double s = q == 0 ? sp : q == 1 ? cp : q == 2 ? -sp : -cp;
    p.rope[e] = make_float2((float)c, (float)s);
  }
}

template <bool FIRST, bool LAST>
DI void e0_phase(const Params& p, const float* xin, float* xout, const float* gpost) {
  const int tid = get_tid(); const int lane = tid & 63, w = tid >> 6;
  for (int row = blockIdx.x * 4 + w; row < NTOK; row += gridDim.x * 4) {
    f32x4 v[4];
#pragma unroll
    for (int c = 0; c < 4; ++c) v[c] = *(const f32x4*)(xin + (size_t)row * 1024 + c * 256 + lane * 4);
    if (!FIRST) {
      float ss = lane < 16 ? p.ssq_out[(size_t)row * 16 + lane] : 0.f;
      ss = wave_sum(ss);
      const float rso = rsqrtf(ss * (1.0f / 1024.0f) + EPSV);
#pragma unroll
      for (int c = 0; c < 4; ++c) {
        const u32x2 ob = *(const u32x2*)(p.gate + (size_t)row * 1024 + c * 256 + lane * 4);
        const f32x4 g = *(const f32x4*)(gpost + c * 256 + lane * 4);
        v[c][0] += bf_lo(ob.x) * rso * g[0]; v[c][1] += bf_hi(ob.x) * rso * g[1];
        v[c][2] += bf_lo(ob.y) * rso * g[2]; v[c][3] += bf_hi(ob.y) * rso * g[3];
        *(f32x4*)(xout + (size_t)row * 1024 + c * 256 + lane * 4) = v[c];
      }
    }
    if (!LAST) {
      float ss = 0.f;
#pragma unroll
      for (int c = 0; c < 4; ++c) {
        ss += v[c][0] * v[c][0] + v[c][1] * v[c][1] + v[c][2] * v[c][2] + v[c][3] * v[c][3];
        *(u32x2*)(p.xb + (size_t)row * 1024 + c * 256 + lane * 4) = pack4(v[c]);
      }
      ss = wave_sum(ss);
      if (lane == 0) p.rs_x[row] = rsqrtf(ss * (1.0f / 1024.0f) + EPSV);
    }
  }
}

#define MFMA16(a, b, c) __builtin_amdgcn_mfma_f32_16x16x32_bf16((a), (b), (c), 0, 0, 0)
#define MFMA32(a, b, c) __builtin_amdgcn_mfma_f32_32x32x16_bf16((a), (b), (c), 0, 0, 0)

template <bool TRV>
DI void gemm_core(const bf16_t* __restrict__ A, const bf16_t* __restrict__ Bt, const int K, const int row0, const int col0, const bool tr,
                  char* lds, f32x4 (&acc)[4][4]) {
  const int tid = get_tid(), lane = tid & 63, wid = tid >> 6, wr = wid >> 1, wc = wid & 1, fr = lane & 15, fq = lane >> 4;
  const int sr = tid >> 3, sc = tid & 7;
  const bf16_t* ga = A + (size_t)(row0 + sr) * K + sc * 8;
  const bf16_t* gb = Bt + (size_t)(col0 + sr) * K + sc * 8;
  const int lw = sr * 128 + ((sc ^ ((sr >> 1) & 7)) << 4);
  const size_t gstep = (size_t)32 * K;
  u32x4 ra[4], rb[4];
#pragma unroll
  for (int m = 0; m < 4; ++m)
#pragma unroll
    for (int n = 0; n < 4; ++n) acc[m][n] = (f32x4){0.f, 0.f, 0.f, 0.f};
  const int nk = K >> 6;
#pragma unroll
  for (int i = 0; i < 4; ++i) { ra[i] = *(const u32x4*)(ga + i * gstep); rb[i] = *(const u32x4*)(gb + i * gstep); }
#pragma unroll
  for (int i = 0; i < 4; ++i) { *(u32x4*)(lds + lw + i * 4096) = ra[i]; *(u32x4*)(lds + 16384 + lw + i * 4096) = rb[i]; }
  __syncthreads();
  const int arow = wr * 64 + fr, brow = wc * 64 + fr;
  const int asw = (arow >> 1) & 7, bsw = (brow >> 1) & 7;
  for (int kt = 0; kt < nk; ++kt) {
    if (kt + 1 < nk) {
#pragma unroll
      for (int i = 0; i < 4; ++i) { ra[i] = *(const u32x4*)(ga + i * gstep + (kt + 1) * 64); rb[i] = *(const u32x4*)(gb + i * gstep + (kt + 1) * 64); }
    }
    const char* sa = lds + (kt & 1) * 32768; const char* sb = sa + 16384;
#pragma unroll
    for (int ks = 0; ks < 2; ++ks) {
      bf16x8 af[4], bfr[4];
#pragma unroll
      for (int m = 0; m < 4; ++m) af[m] = *(const bf16x8*)(sa + (arow + 16 * m) * 128 + (((ks * 4 + fq) ^ asw) << 4));
#pragma unroll
      for (int n = 0; n < 4; ++n) bfr[n] = *(const bf16x8*)(sb + (brow + 16 * n) * 128 + (((ks * 4 + fq) ^ bsw) << 4));
      if (TRV && tr) {
#pragma unroll
        for (int m = 0; m < 4; ++m)
#pragma unroll
          for (int n = 0; n < 4; ++n) acc[m][n] = MFMA16(af[m], bfr[n], acc[m][n]);
      } else {
#pragma unroll
        for (int m = 0; m < 4; ++m)
#pragma unroll
          for (int n = 0; n < 4; ++n) acc[m][n] = MFMA16(bfr[n], af[m], acc[m][n]);
      }
    }
    if (kt + 1 < nk) {
      char* d = lds + ((kt + 1) & 1) * 32768 + lw;
#pragma unroll
      for (int i = 0; i < 4; ++i) { *(u32x4*)(d + i * 4096) = ra[i]; *(u32x4*)(d + 16384 + i * 4096) = rb[i]; }
    }
    __syncthreads();
  }
}

DI void rope4(const float2* rope, int pos, int fq, f32x4& t1, f32x4& t2) {
  const f32x4 cs0 = *(const f32x4*)(rope + pos * 16 + 4 * fq);
  const f32x4 cs1 = *(const f32x4*)(rope + pos * 16 + 4 * fq + 2);
  const float c[4] = {cs0[0], cs0[2], cs1[0], cs1[2]}, s[4] = {cs0[1], cs0[3], cs1[1], cs1[3]};
#pragma unroll
  for (int r = 0; r < 4; ++r) { const float a = t1[r], b = t2[r]; t1[r] = a * c[r] - b * s[r]; t2[r] = a * s[r] + b * c[r]; }
}

template <int EPI>
DI void gemm_tile(const Params& p, const int layer, const int tm, int tn, char* lds) {
  const int tid = get_tid(), lane = tid & 63, wid = tid >> 6, wr = wid >> 1, wc = wid & 1, fr = lane & 15, fq = lane >> 4;
  const int row0 = tm * 128;
  f32x4 acc[4][4];
  if (EPI == 1) {
    gemm_core<false>(p.xb, p.wt_a_in + (size_t)layer * 1536 * 1024, 1024, row0, tn * 128, false, lds, acc);
    float rs[4];
#pragma unroll
    for (int m = 0; m < 4; ++m) rs[m] = p.rs_x[row0 + wr * 64 + m * 16 + fr];
    if (tn <= 2) {
      bf16_t* dst = tn < 2 ? p.cq : p.ckv; const int ld = tn < 2 ? 256 : 128; const int cb = (tn < 2 ? tn * 128 : 0) + wc * 64 + 4 * fq;
      float* sq = tn < 2 ? p.ssq_cq : p.ssq_ckv; const int sld = tn < 2 ? 4 : 2, si = (tn < 2 ? tn * 2 : 0) + wc;
#pragma unroll
      for (int m = 0; m < 4; ++m) {
        const int row = row0 + wr * 64 + m * 16 + fr; float ss = 0.f;
#pragma unroll
        for (int n = 0; n < 4; ++n) { const f32x4 v = acc[m][n] * rs[m]; ss += v[0] * v[0] + v[1] * v[1] + v[2] * v[2] + v[3] * v[3]; *(u32x2*)(dst + (size_t)row * ld + cb + n * 16) = pack4(v); }
        ss += __shfl_xor(ss, 16); ss += __shfl_xor(ss, 32);
        if (fq == 0) sq[(size_t)row * sld + si] = ss;
      }
    } else if (tn <= 10) {
      const int cb = (tn - 3) * 128 + wc * 64 + 4 * fq;
#pragma unroll
      for (int m = 0; m < 4; ++m) {
        const int row = row0 + wr * 64 + m * 16 + fr;
#pragma unroll
        for (int n = 0; n < 4; ++n) { f32x4 v = acc[m][n] * rs[m]; v[0] = silu_f(v[0]); v[1] = silu_f(v[1]); v[2] = silu_f(v[2]); v[3] = silu_f(v[3]); *(u32x2*)(p.gate + (size_t)row * 1024 + cb + n * 16) = pack4(v); }
      }
    } else if (wc == 0) {
#pragma unroll
      for (int m = 0; m < 4; ++m) {
        const int row = row0 + wr * 64 + m * 16 + fr;
        f32x4 t1 = acc[m][0] * rs[m], t2 = acc[m][1] * rs[m];
        rope4(p.rope, row & (SEQL - 1), fq, t1, t2);
        const u32x2 w1 = pack4(t1), w2 = pack4(t2);
        bf16_t* kd = p.Kb + (size_t)row * 1536 + 64 + 4 * fq;
#pragma unroll
        for (int h = 0; h < 16; ++h) { *(u32x2*)(kd + h * 96) = w1; *(u32x2*)(kd + h * 96 + 16) = w2; }
      }
    }
  } else if (EPI == 2) {
    gemm_core<false>(p.cq, p.wt_a_uq + (size_t)layer * 1536 * 256, 256, row0, tn * 128, false, lds, acc);
#pragma unroll
    for (int m = 0; m < 4; ++m) {
      const int row = row0 + wr * 64 + m * 16 + fr;
      const f32x4 sq = *(const f32x4*)(p.ssq_cq + (size_t)row * 4);
      const float rs = rsqrtf((sq[0] + sq[1] + sq[2] + sq[3]) * (1.0f / 256.0f) + EPSV) * QSCALE_A;
#pragma unroll
      for (int n = 0; n < 4; n += 2) {
        const int c0 = tn * 128 + wc * 64 + n * 16;
        f32x4 t1 = acc[m][n] * rs, t2 = acc[m][n + 1] * rs;
        if ((c0 % 96) == 64) rope4(p.rope, row & (SEQL - 1), fq, t1, t2);
        *(u32x2*)(p.Q + (size_t)row * 1536 + c0 + 4 * fq) = pack4(t1);
        *(u32x2*)(p.Q + (size_t)row * 1536 + c0 + 16 + 4 * fq) = pack4(t2);
      }
    }
  } else if (EPI == 3) {
    const bool tr = wc == 1;
    gemm_core<true>(p.ckv, p.wt_a_ukv + (size_t)layer * 2048 * 128, 128, row0, tn * 128, tr, lds, acc);
    if (!tr) {
#pragma unroll
      for (int m = 0; m < 4; ++m) {
        const int row = row0 + wr * 64 + m * 16 + fr;
        const float2 sq = *(const float2*)(p.ssq_ckv + (size_t)row * 2);
        const float rs = rsqrtf((sq.x + sq.y) * (1.0f / 128.0f) + EPSV);
#pragma unroll
        for (int n = 0; n < 4; ++n) *(u32x2*)(p.Kb + (size_t)row * 1536 + tn * 96 + n * 16 + 4 * fq) = pack4(acc[m][n] * rs);
      }
    } else {
      const int b = row0 >> 12;
#pragma unroll
      for (int m = 0; m < 4; ++m) {
        const int rowb = row0 + wr * 64 + m * 16 + 4 * fq;
        f32x4 rs;
#pragma unroll
        for (int r = 0; r < 4; ++r) { const float2 sq = *(const float2*)(p.ssq_ckv + (size_t)(rowb + r) * 2); rs[r] = rsqrtf((sq.x + sq.y) * (1.0f / 128.0f) + EPSV); }
#pragma unroll
        for (int n = 0; n < 4; ++n) *(u32x2*)(p.Vt + ((size_t)(b * 16 + tn) * 64 + n * 16 + fr) * SEQL + (rowb & (SEQL - 1))) = pack4(acc[m][n] * rs);
      }
    }
  } else if (EPI == 4) {
    const int sec = layer == 0 ? (tn >> 3) : 2 + (tn >> 3);
    const bool tr = sec == 1;
    const bf16_t* Bt = layer == 0 ? p.wt_b1 : p.wt_b1 + (size_t)2 * 2048 * 1024;
    gemm_core<true>(p.xb, Bt, 1024, row0, tn * 128, tr, lds, acc);
    const int cw = (tn & 7) * 128 + wc * 64;
    if (!tr) {
#pragma unroll
      for (int m = 0; m < 4; ++m) {
        const int row = row0 + wr * 64 + m * 16 + fr;
        const float rs = p.rs_x[row] * (sec == 2 ? QSCALE_B : 1.0f);
        bf16_t* dst = (sec == 0 ? p.Kb : sec == 2 ? p.Q : p.gate) + (size_t)row * 1024 + cw + 4 * fq;
#pragma unroll
        for (int n = 0; n < 4; ++n) { f32x4 v = acc[m][n] * rs; if (sec == 3) { v[0] = silu_f(v[0]); v[1] = silu_f(v[1]); v[2] = silu_f(v[2]); v[3] = silu_f(v[3]); } *(u32x2*)(dst + n * 16) = pack4(v); }
      }
    } else {
      const int b = row0 >> 12, h = cw >> 6;
#pragma unroll
      for (int m = 0; m < 4; ++m) {
        const int rowb = row0 + wr * 64 + m * 16 + 4 * fq;
        const f32x4 rs = *(const f32x4*)(p.rs_x + rowb);
#pragma unroll
        for (int n = 0; n < 4; ++n) *(u32x2*)(p.Vt + ((size_t)(b * 16 + h) * 64 + n * 16 + fr) * SEQL + (rowb & (SEQL - 1))) = pack4(acc[m][n] * rs);
      }
    }
  } else {
    const bf16_t* Bt = layer < 2 ? p.wt_a_o + (size_t)layer * 1024 * 1024 : p.wt_b_o + (size_t)(layer - 2) * 1024 * 1024;
    gemm_core<false>(p.xb, Bt, 1024, row0, tn * 128, false, lds, acc);
#pragma unroll
    for (int m = 0; m < 4; ++m) {
      const int row = row0 + wr * 64 + m * 16 + fr; float ss = 0.f;
#pragma unroll
      for (int n = 0; n < 4; ++n) { const f32x4 v = acc[m][n]; ss += v[0] * v[0] + v[1] * v[1] + v[2] * v[2] + v[3] * v[3]; *(u32x2*)(p.gate + (size_t)row * 1024 + tn * 128 + wc * 64 + n * 16 + 4 * fq) = pack4(v); }
      ss += __shfl_xor(ss, 16); ss += __shfl_xor(ss, 32);
      if (fq == 0) p.ssq_out[(size_t)row * 16 + tn * 2 + wc] = ss;
    }
  }
}

template <int EPI>
DI void gemm_phase(const Params& p, const int layer, char* lds) {
  const int nN = EPI == 1 ? 12 : EPI == 23 ? 28 : EPI == 4 ? (layer == 0 ? 32 : 16) : 8;
  const int U = 256 * nN;
  for (int L = blockIdx.x; L < U; L += gridDim.x) {
    const int u = (L & 7) * (U >> 3) + (L >> 3);
    const int tm = u / nN, tn = u % nN;
    if (EPI == 23) { if (tn < 12) gemm_tile<2>(p, layer, tm, tn, lds); else gemm_tile<3>(p, layer, tm, tn - 12, lds); }
    else gemm_tile<(EPI == 23 ? 2 : EPI)>(p, layer, tm, tn, lds);
  }
}

template <bool SB>
DI void attn_unit(const Params& p, const int b, const int h, const int qb, char* lds, unsigned* sflags) {
  constexpr int DQK = SB ? 64 : 96, KS = DQK / 16, KROWB = SB ? 128 : 256, KBUF = 64 * KROWB, VBUF = 64 * 128, STG = KBUF + VBUF;
  constexpr int LD = 16 * DQK, KCH = DQK / 8, NKC = 64 * KCH / 256;
  const int tid = get_tid(), lane = tid & 63, w = tid >> 6, r = lane & 31, hh = lane >> 5;
  const int q0 = qb * 128, qrow = q0 + 32 * w + r;
  const size_t tok0 = (size_t)b * SEQL;
  bf16x8 qf[KS];
  {
    const bf16_t* Qp = p.Q + (tok0 + qrow) * LD + h * DQK + 8 * hh;
#pragma unroll
    for (int s = 0; s < KS; ++s) qf[s] = *(const bf16x8*)(Qp + 16 * s);
  }
  const bf16_t* Kg = p.Kb + tok0 * LD + h * DQK;
  const bf16_t* Vg = p.Vt + ((size_t)(b * 16 + h) * 64) * SEQL;
  int kgo[NKC], klo[NKC];
#pragma unroll
  for (int i = 0; i < NKC; ++i) { const int c = tid + 256 * i, key = c / KCH, cc = c % KCH; kgo[i] = key * LD + cc * 8; klo[i] = key * KROWB + ((cc ^ (SB ? ((key >> 1) & 7) : (key & 15))) << 4); }
  int vgo[2], vlo[2];
#pragma unroll
  for (int i = 0; i < 2; ++i) { const int c = tid + 256 * i, dv = c >> 3, cc = c & 7; vgo[i] = dv * SEQL + cc * 8; vlo[i] = KBUF + dv * 128 + (((2 * cc) ^ ((dv >> 1) & 15)) << 3); }
  u32x4 kreg[NKC], vreg[2];
  f32x16 o0, o1;
#pragma unroll
  for (int i = 0; i < 16; ++i) { o0[i] = 0.f; o1[i] = 0.f; }
  float m_run = -INFINITY, l_run = 0.f, carry = 0.f;
  bool done_w = false;
  const int n = 2 * qb + 2;
#define ATT_LOAD(k0_) do { _Pragma("unroll") for (int i_ = 0; i_ < NKC; ++i_) kreg[i_] = *(const u32x4*)(Kg + (size_t)(k0_) * LD + kgo[i_]); \
    _Pragma("unroll") for (int i_ = 0; i_ < 2; ++i_) vreg[i_] = *(const u32x4*)(Vg + (k0_) + vgo[i_]); } while (0)
#define ATT_WRITE(sb_) do { char* base_ = lds + (sb_) * STG; _Pragma("unroll") for (int i_ = 0; i_ < NKC; ++i_) *(u32x4*)(base_ + klo[i_]) = kreg[i_]; \
    _Pragma("unroll") for (int i_ = 0; i_ < 2; ++i_) { u32x2 lo_, hi_; lo_.x = vreg[i_].x; lo_.y = vreg[i_].y; hi_.x = vreg[i_].z; hi_.y = vreg[i_].w; \
      *(u32x2*)(base_ + vlo[i_]) = lo_; *(u32x2*)(base_ + (vlo[i_] ^ 8)) = hi_; } } while (0)
  { const int k0 = SB ? (n - 1) * 64 : 0; ATT_LOAD(k0); }
  ATT_WRITE(0);
  __syncthreads();
  const int ksw0 = SB ? ((r >> 1) & 7) : (r & 15);
  const int vsw = (r >> 1) & 15;
  for (int idx = 0; idx < n; ++idx) {
    const int k0 = SB ? (n - 1 - idx) * 64 : idx * 64;
    if (idx + 1 < n) { const int k1 = SB ? (n - 2 - idx) * 64 : (idx + 1) * 64; ATT_LOAD(k1); }
    const char* kb = lds + (idx & 1) * STG; const char* vb = kb + KBUF;
    const bool skip = SB ? (k0 >= q0 + 32 * w + 31) : (k0 > q0 + 32 * w + 31);
    if (!skip && !done_w) {
      f32x16 s0, s1;
#pragma unroll
      for (int i = 0; i < 16; ++i) { s0[i] = 0.f; s1[i] = 0.f; }
#pragma unroll
      for (int ks = 0; ks < KS; ++ks) {
        const int co = ((2 * ks + hh) ^ ksw0) << 4;
        const bf16x8 k0f = *(const bf16x8*)(kb + r * KROWB + co);
        const bf16x8 k1f = *(const bf16x8*)(kb + (32 + r) * KROWB + co);
        s0 = MFMA32(k0f, qf[ks], s0);
        s1 = MFMA32(k1f, qf[ks], s1);
      }
      const int kbase = k0 + 4 * hh;
      if (!SB) {
        if (k0 + 63 > q0 + 32 * w) {
#pragma unroll
          for (int i = 0; i < 16; ++i) {
            const int key = kbase + (i & 3) + 8 * (i >> 2);
            if (key > qrow) s0[i] = -INFINITY;
            if (key + 32 > qrow) s1[i] = -INFINITY;
          }
        }
        float mx = s0[0];
#pragma unroll
        for (int i = 1; i < 16; ++i) mx = fmaxf(mx, s0[i]);
#pragma unroll
        for (int i = 0; i < 16; ++i) mx = fmaxf(mx, s1[i]);
        mx = fmaxf(mx, __shfl_xor(mx, 32));
        const float m_new = fmaxf(m_run, mx);
        const float alpha = __builtin_amdgcn_exp2f(m_run - m_new);
        m_run = m_new;
        float ps = 0.f;
#pragma unroll
        for (int i = 0; i < 16; ++i) { s0[i] = __builtin_amdgcn_exp2f(s0[i] - m_new); s1[i] = __builtin_amdgcn_exp2f(s1[i] - m_new); ps += s0[i] + s1[i]; }
        l_run = l_run * alpha + ps;
#pragma unroll
        for (int i = 0; i < 16; ++i) { o0[i] *= alpha; o1[i] *= alpha; }
      } else {
        const bool need_mask = k0 + 63 >= q0 + 32 * w;
#pragma unroll
        for (int kt = 1; kt >= 0; --kt) {
          f32x16& sv = kt ? s1 : s0;
          float lr[16];
#pragma unroll
          for (int i = 0; i < 16; ++i) {
            const float z = sv[i];
            const float t = __builtin_amdgcn_logf(1.0f + __builtin_amdgcn_exp2f(-fabsf(z)));
            float l = -(fmaxf(z, 0.f) + t);
            sv[i] = fminf(z, 0.f) - t;
            if (need_mask) { const int key = kbase + 32 * kt + (i & 3) + 8 * (i >> 2); if (key >= qrow) { l = 0.f; sv[i] = -INFINITY; } }
            lr[i] = l;
          }
          float G[4], Go[4];
#pragma unroll
          for (int m = 0; m < 4; ++m) { G[m] = (lr[4 * m] + lr[4 * m + 1]) + (lr[4 * m + 2] + lr[4 * m + 3]); Go[m] = __shfl_xor(G[m], 32); }
          float run = carry;
#pragma unroll
          for (int m = 3; m >= 0; --m) {
            float a = run + (hh == 0 ? Go[m] : 0.f);
            sv[4 * m + 3] = __builtin_amdgcn_exp2f(sv[4 * m + 3] + a); a += lr[4 * m + 3];
            sv[4 * m + 2] = __builtin_amdgcn_exp2f(sv[4 * m + 2] + a); a += lr[4 * m + 2];
            sv[4 * m + 1] = __builtin_amdgcn_exp2f(sv[4 * m + 1] + a); a += lr[4 * m + 1];
            sv[4 * m + 0] = __builtin_amdgcn_exp2f(sv[4 * m + 0] + a);
            run += G[m] + Go[m];
          }
          carry = run;
        }
        done_w = __all(carry < SB_DONE_THR);
      }
      bf16x8 pf[4];
      {
        u32x4 t;
        t.x = pk_bf16(s0[0], s0[1]); t.y = pk_bf16(s0[2], s0[3]); t.z = pk_bf16(s0[4], s0[5]); t.w = pk_bf16(s0[6], s0[7]); pf[0] = __builtin_bit_cast(bf16x8, t);
        t.x = pk_bf16(s0[8], s0[9]); t.y = pk_bf16(s0[10], s0[11]); t.z = pk_bf16(s0[12], s0[13]); t.w = pk_bf16(s0[14], s0[15]); pf[1] = __builtin_bit_cast(bf16x8, t);
        t.x = pk_bf16(s1[0], s1[1]); t.y = pk_bf16(s1[2], s1[3]); t.z = pk_bf16(s1[4], s1[5]); t.w = pk_bf16(s1[6], s1[7]); pf[2] = __builtin_bit_cast(bf16x8, t);
        t.x = pk_bf16(s1[8], s1[9]); t.y = pk_bf16(s1[10], s1[11]); t.z = pk_bf16(s1[12], s1[13]); t.w = pk_bf16(s1[14], s1[15]); pf[3] = __builtin_bit_cast(bf16x8, t);
      }
#pragma unroll
      for (int s4 = 0; s4 < 4; ++s4) {
        const int c0 = ((4 * s4 + hh) ^ vsw) << 3, c1 = ((4 * s4 + 2 + hh) ^ vsw) << 3;
        {
          const s16x4 lo = *(const s16x4*)(vb + r * 128 + c0), hi = *(const s16x4*)(vb + r * 128 + c1);
          o0 = MFMA32(__builtin_shufflevector(lo, hi, 0, 1, 2, 3, 4, 5, 6, 7), pf[s4], o0);
        }
        {
          const s16x4 lo = *(const s16x4*)(vb + (32 + r) * 128 + c0), hi = *(const s16x4*)(vb + (32 + r) * 128 + c1);
          o1 = MFMA32(__builtin_shufflevector(lo, hi, 0, 1, 2, 3, 4, 5, 6, 7), pf[s4], o1);
        }
      }
    }
    if (SB) { if (lane == 0) sflags[(idx & 1) * 4 + w] = done_w ? 1u : 0u; }
    if (idx + 1 < n) ATT_WRITE((idx + 1) & 1);
    __syncthreads();
    if (SB) { const unsigned* f = sflags + (idx & 1) * 4; if (f[0] & f[1] & f[2] & f[3]) break; }
  }
#undef ATT_LOAD
#undef ATT_WRITE
  float inv = 1.0f;
  if (!SB) { const float lt = l_run + __shfl_xor(l_run, 32); inv = 1.0f / lt; }
  const size_t obase = (tok0 + qrow) * 1024 + h * 64 + 4 * hh;
#pragma unroll
  for (int dt = 0; dt < 2; ++dt) {
    const f32x16& ov = dt ? o1 : o0;
#pragma unroll
    for (int g = 0; g < 4; ++g) {
      const size_t off = obase + dt * 32 + 8 * g;
      const u32x2 gw = *(const u32x2*)(p.gate + off);
      f32x4 v;
      v[0] = ov[4 * g + 0] * inv * bf_lo(gw.x); v[1] = ov[4 * g + 1] * inv * bf_hi(gw.x);
      v[2] = ov[4 * g + 2] * inv * bf_lo(gw.y); v[3] = ov[4 * g + 3] * inv * bf_hi(gw.y);
      *(u32x2*)(p.xb + off) = pack4(v);
    }
  }
}

template <bool SB>
DI void attn_phase(const Params& p, const int slot, char* lds, unsigned* sflags, int* s_unit) {
  const int grp0 = blockIdx.x & 7;
  for (int j = 0; j < 8; ++j) {
    const int g = (grp0 + j) & 7;
    for (;;) {
      if (threadIdx.x == 0) *s_unit = (int)atomicAdd(p.counters + slot * 8 + g, 1u);
      __syncthreads();
      const int l = *s_unit;
      __syncthreads();
      if (l >= 512) break;
      const int bh = g + 8 * (l & 15), qb = 31 - (l >> 4);
      attn_unit<SB>(p, bh >> 4, bh & 15, qb, lds, sflags);
    }
  }
}

__global__ void __launch_bounds__(256, 2) mk_fwd(Params p, int ph_lo, int ph_hi) {
  __shared__ __attribute__((aligned(16))) char lds[65536];
  __shared__ unsigned sflags[8];
  __shared__ int s_unit;
  for (int ph = ph_lo; ph < ph_hi; ++ph) {
#ifndef DBG_SEL
#define DBG_SEL 0xffff
#endif
#define SEL(b) ((DBG_SEL >> (b)) & 1)
    if (ph == 0) {
      if (blockIdx.x == 0 && threadIdx.x < 64) p.counters[threadIdx.x] = 0u;
      if (SEL(0)) conv_phase(p, lds);
      if (SEL(0)) rope_phase(p);
      if (SEL(5)) e0_phase<true, false>(p, p.x, nullptr, nullptr);
    } else if (ph <= 10) {
      const int layer = (ph - 1) / 5, sub = (ph - 1) % 5;
      if (sub == 0) { if (SEL(1)) gemm_phase<1>(p, layer, lds); }
      else if (sub == 1) { if (SEL(2)) gemm_phase<23>(p, layer, lds); }
      else if (sub == 2) { if (SEL(3)) attn_phase<false>(p, layer, lds, sflags, &s_unit); }
      else if (sub == 3) { if (SEL(4)) gemm_phase<5>(p, layer, lds); }
      else if (SEL(5)) e0_phase<false, false>(p, layer == 0 ? p.x : p.out, p.out, p.a_norm_post + layer * 1024);
    } else {
      const int layer = (ph - 11) / 4, sub = (ph - 11) % 4;
      if (sub == 0) { if (SEL(6)) gemm_phase<4>(p, layer, lds); }
      else if (sub == 1) { if (SEL(7)) attn_phase<true>(p, 2 + layer, lds, sflags, &s_unit); }
      else if (sub == 2) { if (SEL(4)) gemm_phase<5>(p, 2 + layer, lds); }
      else if (!SEL(5)) {}
      else if (layer == 0) e0_phase<false, false>(p, p.out, p.out, p.b_norm_post);
      else e0_phase<false, true>(p, p.out, p.out, p.b_norm_post + 1024);
    }
    if (ph + 1 < ph_hi) cg::this_grid().sync();
  }
}

extern "C" void kernel_launch(void* const* d_in, const int* in_sizes, int n_in, void* d_out, int out_size, void* d_ws, size_t ws_size, hipStream_t stream) {
  (void)in_sizes; (void)n_in; (void)out_size;
  Params p{};
  p.x = (const float*)d_in[0]; p.a_norm_pre = (const float*)d_in[1]; p.a_w_in = (const float*)d_in[2]; p.a_q_norm = (const float*)d_in[3];
  p.a_w_uq = (const float*)d_in[4]; p.a_kv_norm = (const float*)d_in[5]; p.a_w_ukv = (const float*)d_in[6]; p.a_w_o = (const float*)d_in[7];
  p.a_norm_post = (const float*)d_in[8]; p.b_kv_norm = (const float*)d_in[9]; p.b_w_kv = (const float*)d_in[10]; p.b_norm_pre = (const float*)d_in[11];
  p.b_w_in = (const float*)d_in[12]; p.b_w_o = (const float*)d_in[13]; p.b_norm_post = (const float*)d_in[14];
  p.out = (float*)d_out;
  char* w = (char*)d_ws; size_t off = 0;
  auto take = [&](size_t bytes) { char* r = w + off; off += (bytes + 255) & ~(size_t)255; return r; };
  p.wt_a_in = (bf16_t*)take((size_t)2 * 1536 * 1024 * 2);
  p.wt_a_uq = (bf16_t*)take((size_t)2 * 1536 * 256 * 2);
  p.wt_a_ukv = (bf16_t*)take((size_t)2 * 2048 * 128 * 2);
  p.wt_a_o = (bf16_t*)take((size_t)2 * 1024 * 1024 * 2);
  p.wt_b1 = (bf16_t*)take((size_t)3 * 2048 * 1024 * 2);
  p.wt_b_o = (bf16_t*)take((size_t)2 * 1024 * 1024 * 2);
  p.xb = (bf16_t*)take((size_t)NTOK * 1024 * 2);
  p.cq = (bf16_t*)take((size_t)NTOK * 256 * 2);
  p.ckv = (bf16_t*)take((size_t)NTOK * 128 * 2);
  p.gate = (bf16_t*)take((size_t)NTOK * 1024 * 2);
  p.Q = (bf16_t*)take((size_t)NTOK * 1536 * 2);
  p.Kb = (bf16_t*)take((size_t)NTOK * 1536 * 2);
  p.Vt = (bf16_t*)take((size_t)NTOK * 1024 * 2);
  p.rs_x = (float*)take((size_t)NTOK * 4);
  p.ssq_cq = (float*)take((size_t)NTOK * 4 * 4);
  p.ssq_ckv = (float*)take((size_t)NTOK * 2 * 4);
  p.ssq_out = (float*)take((size_t)NTOK * 16 * 4);
  p.rope = (float2*)take((size_t)SEQL * 16 * 8);
  p.counters = (unsigned*)take(256);
  if (off > ws_size) { fprintf(stderr, "workspace too small: need %zu have %zu\n", off, ws_size); return; }
  static int grid_blocks = 0;
  if (!grid_blocks) {
    int dev = 0, cus = 0, per_cu = 0;
    hipGetDevice(&dev);
    hipDeviceGetAttribute(&cus, hipDeviceAttributeMultiprocessorCount, dev);
    hipOccupancyMaxActiveBlocksPerMultiprocessor(&per_cu, mk_fwd, 256, 0);
    if (per_cu < 1) per_cu = 1;
    if (per_cu > 2) per_cu = 2;
    grid_blocks = cus * per_cu;
  }
#if ONE_LAUNCH
  int lo = 0, hi = NPHASE;
  void* args[] = {&p, &lo, &hi};
  hipError_t e = hipLaunchCooperativeKernel((void*)mk_fwd, dim3(grid_blocks), dim3(256), args, 0, stream);
  if (e != hipSuccess) fprintf(stderr, "cooperative launch failed: %s (grid %d)\n", hipGetErrorString(e), grid_blocks);
#else
  for (int ph = 0; ph < NPHASE; ++ph) mk_fwd<<<dim3(grid_blocks), dim3(256), 0, stream>>>(p, ph, ph + 1);
#endif
}
```

```cpp
#include <hip/hip_runtime.h>
#include <hip/hip_cooperative_groups.h>
#include <cstdio>
#include <cstdint>
namespace cg = cooperative_groups;

#ifndef ONE_LAUNCH
#define ONE_LAUNCH 1
#endif

typedef unsigned short bf16_t;
typedef short bf16x8 __attribute__((ext_vector_type(8)));
typedef short s16x4 __attribute__((ext_vector_type(4)));
typedef float f32x4 __attribute__((ext_vector_type(4)));
typedef float f32x16 __attribute__((ext_vector_type(16)));
typedef unsigned u32x4 __attribute__((ext_vector_type(4)));
typedef unsigned u32x2 __attribute__((ext_vector_type(2)));

#define DI __device__ __forceinline__
#define NTOK 32768
#define SEQL 4096
#define EPSV 1e-6f
#define NPHASE 19
#define LOG2E 1.4426950408889634f
#define QSCALE_A (0.10206207261596577f * LOG2E)
#define QSCALE_B (0.125f * LOG2E)
#define SB_DONE_THR 1e-20f

struct Params {
  const float* x; const float* a_norm_pre; const float* a_w_in; const float* a_q_norm; const float* a_w_uq;
  const float* a_kv_norm; const float* a_w_ukv; const float* a_w_o; const float* a_norm_post;
  const float* b_kv_norm; const float* b_w_kv; const float* b_norm_pre; const float* b_w_in; const float* b_w_o; const float* b_norm_post;
  float* out;
  bf16_t* wt_a_in; bf16_t* wt_a_uq; bf16_t* wt_a_ukv; bf16_t* wt_a_o; bf16_t* wt_b1; bf16_t* wt_b_o;
  bf16_t* xb;
  bf16_t* og;
  bf16_t* cq; bf16_t* ckv;
  bf16_t* gate;
  bf16_t* Q; bf16_t* Kb; bf16_t* Vt; bf16_t* kr;
  float* rs_x; float* ssq_cq; float* ssq_ckv; float* ssq_out; float2* rope; unsigned* bar; unsigned* counters;
};

typedef float f32x2 __attribute__((ext_vector_type(2)));
typedef __bf16 bf16x2n __attribute__((ext_vector_type(2)));
DI unsigned pk_bf16(float lo, float hi) { f32x2 v; v.x = lo; v.y = hi; return __builtin_bit_cast(unsigned, __builtin_convertvector(v, bf16x2n)); }
DI int get_tid() { int t = threadIdx.x; asm volatile("" : "+v"(t)); return t; }
DI float bf_lo(unsigned u) { return __uint_as_float(u << 16); }
DI float bf_hi(unsigned u) { return __uint_as_float(u & 0xffff0000u); }
DI float wave_sum(float v) {
#pragma unroll
  for (int o = 32; o > 0; o >>= 1) v += __shfl_xor(v, o);
  return v;
}
DI float silu_f(float v) { return v * __builtin_amdgcn_rcpf(1.0f + __builtin_amdgcn_exp2f(-v * LOG2E)); }
DI u32x2 pack4(f32x4 v) { u32x2 w; w.x = pk_bf16(v[0], v[1]); w.y = pk_bf16(v[2], v[3]); return w; }


#define XB_TMO      128
#define XB_XCNT(j)  (256  + 64 * (j))
#define XB_XSUB(j)  (1280 + 64 * (j))
#define XB_XGEN(j)  (2304 + 64 * (j))
#define XB_TOP      3328
#define XB_TOPGEN   3392
#define XCD_BAR_WORDS 3456
#define XB_SPIN_CAP (1u << 22)
#define LAS __attribute__((address_space(3)))
DI unsigned xb_ld(unsigned* p) { return __hip_atomic_load(p, __ATOMIC_RELAXED, __HIP_MEMORY_SCOPE_AGENT); }
DI unsigned xb_add(unsigned* p, unsigned v) { return __hip_atomic_fetch_add(p, v, __ATOMIC_RELAXED, __HIP_MEMORY_SCOPE_AGENT); }
DI unsigned xb_xcc_id() { return (unsigned)__builtin_amdgcn_s_getreg((3 << 11) | 20) & 0xFu; }
#define XB_SPIN(cond, bar) do { unsigned _sp = 0; while (cond) { __builtin_amdgcn_s_sleep(1); \
    if ((++_sp & 255u) == 0u) { if (xb_ld(&(bar)[XB_TMO])) break; if (_sp > XB_SPIN_CAP) { atomicAdd(&(bar)[XB_TMO], 1u); break; } } } } while (0)
struct XcdBarrier { unsigned* bar; unsigned x; volatile LAS unsigned* st; };
DI XcdBarrier xcd_barrier_post(unsigned* bar, volatile LAS unsigned* st) {
  XcdBarrier b; b.bar = bar; b.x = xb_xcc_id(); b.st = st;
  if (threadIdx.x == 0) (void)xb_add(&bar[XB_XCNT(b.x)], 1u);
  return b;
}
DI void xcd_barrier_complete(unsigned* bar, unsigned x, unsigned& nloc, unsigned& nx) {
  const unsigned G = gridDim.x * gridDim.y * gridDim.z;
  unsigned sum, cnt, mine, sp = 0u;
  for (;;) {
    sum = 0u; cnt = 0u; mine = 0u;
#pragma unroll
    for (unsigned j = 0; j < 16; ++j) { const unsigned c = xb_ld(&bar[XB_XCNT(j)]); sum += c; cnt += (c > 0u) ? 1u : 0u; mine = (j == x) ? c : mine; }
    if (sum == G) break;
    __builtin_amdgcn_s_sleep(1);
    if ((++sp & 255u) == 0u) { if (xb_ld(&bar[XB_TMO])) break; if (sp > XB_SPIN_CAP) { atomicAdd(&bar[XB_TMO], 1u); break; } }
  }
  nloc = mine > 0u ? mine : 1u; nx = cnt > 0u ? cnt : 1u;
}
DI void xcd_barrier(const XcdBarrier& b) {
  asm volatile("s_waitcnt vmcnt(0)" ::: "memory");
  __syncthreads();
  if (threadIdx.x == 0) {
    unsigned* bar = b.bar;
    __builtin_amdgcn_s_waitcnt(0);
    unsigned nloc = b.st[0], nx = b.st[1];
    if (nloc == 0u) { xcd_barrier_complete(bar, b.x, nloc, nx); b.st[0] = nloc; b.st[1] = nx; }
    const unsigned old = xb_add(&bar[XB_XSUB(b.x)], 1u);
    const unsigned gen = old / nloc;
    if (old + 1u == (gen + 1u) * nloc) {
      __builtin_amdgcn_fence(__ATOMIC_RELEASE, "agent");
      asm volatile("s_waitcnt vmcnt(0)" ::: "memory");
      const unsigned og = xb_add(&bar[XB_TOP], 1u);
      const unsigned tg = og / nx;
      if (og + 1u == (tg + 1u) * nx) xb_add(&bar[XB_TOPGEN], 1u);
      else XB_SPIN(xb_ld(&bar[XB_TOPGEN]) == tg, bar);
      __builtin_amdgcn_fence(__ATOMIC_ACQUIRE, "agent");
      xb_add(&bar[XB_XGEN(b.x)], 1u);
      asm volatile("s_waitcnt vmcnt(0)" ::: "memory");
    } else {
      XB_SPIN(xb_ld(&bar[XB_XGEN(b.x)]) == gen, bar);
      __builtin_amdgcn_fence(__ATOMIC_ACQUIRE, "agent");
      asm volatile("s_waitcnt vmcnt(0)" ::: "memory");
    }
  }
  __syncthreads();
}

struct ConvJob { const float* src; const float* gain; bf16_t* dst; int K, Nsrc, map, n0, k0; };
DI ConvJob conv_decode(const Params& p, int t) {
  ConvJob j; j.map = 0; int tt = t; int i;
  if (tt < 768) { i = tt / 384; tt %= 384; j.src = p.a_w_in + (size_t)i * 1024 * 1440; j.gain = p.a_norm_pre + i * 1024; j.dst = p.wt_a_in + (size_t)i * 1536 * 1024; j.K = 1024; j.Nsrc = 1440; j.map = 1; }
  else if ((tt -= 768) < 192) { i = tt / 96; tt %= 96; j.src = p.a_w_uq + (size_t)i * 256 * 1536; j.gain = p.a_q_norm + i * 256; j.dst = p.wt_a_uq + (size_t)i * 1536 * 256; j.K = 256; j.Nsrc = 1536; }
  else if ((tt -= 192) < 128) { i = tt / 64; tt %= 64; j.src = p.a_w_ukv + (size_t)i * 128 * 2048; j.gain = p.a_kv_norm + i * 128; j.dst = p.wt_a_ukv + (size_t)i * 2048 * 128; j.K = 128; j.Nsrc = 2048; j.map = 2; }
  else if ((tt -= 128) < 512) { i = tt / 256; tt %= 256; j.src = p.a_w_o + (size_t)i * 1024 * 1024; j.gain = nullptr; j.dst = p.wt_a_o + (size_t)i * 1024 * 1024; j.K = 1024; j.Nsrc = 1024; }
  else if ((tt -= 512) < 512) { j.src = p.b_w_kv; j.gain = p.b_kv_norm; j.dst = p.wt_b1; j.K = 1024; j.Nsrc = 2048; }
  else if ((tt -= 512) < 1024) { i = tt / 512; tt %= 512; j.src = p.b_w_in + (size_t)i * 1024 * 2048; j.gain = p.b_norm_pre + i * 1024; j.dst = p.wt_b1 + (size_t)(1 + i) * 2048 * 1024; j.K = 1024; j.Nsrc = 2048; }
  else { tt -= 1024; i = tt / 256; tt %= 256; j.src = p.b_w_o + (size_t)i * 1024 * 1024; j.gain = nullptr; j.dst = p.wt_b_o + (size_t)i * 1024 * 1024; j.K = 1024; j.Nsrc = 1024; }
  const int nkt = j.K >> 6; j.n0 = (tt / nkt) * 64; j.k0 = (tt % nkt) * 64;
  return j;
}
DI void conv_load(const ConvJob& j, int tid, f32x4 (&v)[4]) {
  const int n = j.n0 + (tid & 15) * 4; int sc = n;
  if (j.map == 1) sc = n < 384 ? n : (n < 1408 ? n + 32 : (n < 1440 ? n - 1408 + 384 : -1));
  if (j.map == 2) sc = ((n & 1023) >> 6) * 128 + (n >> 10) * 64 + (n & 63);
#pragma unroll
  for (int r = 0; r < 4; ++r) {
    const int kk = (tid >> 4) + 16 * r; v[r] = (f32x4){0.f, 0.f, 0.f, 0.f};
    if (sc >= 0) { v[r] = *(const f32x4*)(j.src + (size_t)(j.k0 + kk) * j.Nsrc + sc); if (j.gain) v[r] = v[r] * j.gain[j.k0 + kk]; }
  }
}
DI void conv_phase(const Params& p, char* lds) {
  const int tid512 = get_tid(), half = tid512 >> 8, tid = tid512 & 255;
  float (*tile)[65] = (float (*)[65])(lds + half * 16640);
  int t = blockIdx.x * 2 + half;
  if (t >= 3648) return;
  ConvJob J = conv_decode(p, t);
  f32x4 v[4];
  conv_load(J, tid, v);
  for (;;) {
    {
      const int nn = (tid & 15) * 4;
#pragma unroll
      for (int r = 0; r < 4; ++r) { const int kk = (tid >> 4) + 16 * r; tile[kk][nn] = v[r][0]; tile[kk][nn + 1] = v[r][1]; tile[kk][nn + 2] = v[r][2]; tile[kk][nn + 3] = v[r][3]; }
    }
    __syncthreads();
    const int tnx = t + gridDim.x * 2; const bool more = tnx < 3648;
    ConvJob Jn = J;
    if (more) { Jn = conv_decode(p, tnx); conv_load(Jn, tid, v); }
    {
      const int nn = tid >> 2, kc = (tid & 3) * 16;
      u32x4 w0, w1;
      w0.x = pk_bf16(tile[kc + 0][nn], tile[kc + 1][nn]); w0.y = pk_bf16(tile[kc + 2][nn], tile[kc + 3][nn]);
      w0.z = pk_bf16(tile[kc + 4][nn], tile[kc + 5][nn]); w0.w = pk_bf16(tile[kc + 6][nn], tile[kc + 7][nn]);
      w1.x = pk_bf16(tile[kc + 8][nn], tile[kc + 9][nn]); w1.y = pk_bf16(tile[kc + 10][nn], tile[kc + 11][nn]);
      w1.z = pk_bf16(tile[kc + 12][nn], tile[kc + 13][nn]); w1.w = pk_bf16(tile[kc + 14][nn], tile[kc + 15][nn]);
      bf16_t* d = J.dst + (size_t)(J.n0 + nn) * J.K + J.k0 + kc;
      *(u32x4*)d = w0; *(u32x4*)(d + 8) = w1;
    }
    __syncthreads();
    if (!more) break;
    J = Jn; t = tnx;
  }
}

DI void rope_phase(const Params& p) {
  for (int e = blockIdx.x * 512 + get_tid(); e < SEQL * 16; e += gridDim.x * 512) {
    const int pos = e >> 4, i = e & 15;
    const double bs = (i & 3) == 0 ? 1.0 : (i & 3) == 1 ? 0.56234132519034907 : (i & 3) == 2 ? 0.31622776601683794 : 0.17782794100389228;
    const double sc = (i >> 2) == 0 ? 1.0 : (i >> 2) == 1 ? 0.1 : (i >> 2) == 2 ? 0.01 : 0.001;
    const float inv = (float)(bs * sc);
    const float angf = (float)pos * inv;
    const double a = (double)angf;
    const double n = rint(a * 0.63661977236758134);
    double r = fma(-n, 1.5707963267948966, a); r = fma(-n, 6.123233995736766e-17, r);
    const double r2 = r * r;
    const double sp = r * (1.0 + r2 * (-1.0 / 6.0 + r2 * (1.0 / 120.0 + r2 * (-1.0 / 5040.0 + r2 * (1.0 / 362880.0 + r2 * (-1.0 / 39916800.0 + r2 * (1.0 / 6227020800.0)))))));
    const double cp = 1.0 + r2 * (-0.5 + r2 * (1.0 / 24.0 + r2 * (-1.0 / 720.0 + r2 * (1.0 / 40320.0 + r2 * (-1.0 / 3628800.0 + r2 * (1.0 / 479001600.0 + r2 * (-1.0 / 87178291200.0)))))));
    const int q = ((int)n) & 3;
    const double c = q == 0 ? cp : q == 1 ? -sp : q == 2 ? -cp : sp;
    const double s = q == 0 ? sp : q == 1 ? cp : q == 2 ? -sp : -cp;
    p.rope[e] = make_float2((float)c, (float)s);
  }
}

template <int MODE>
DI void e0_phase(const Params& p, const float* gpost) {
  const int tid = get_tid(); const int lane = tid & 63, w = tid >> 6;
  const int step = gridDim.x * 8;
  f32x4 g0[2], g1[2];
#pragma unroll
  for (int c = 0; c < 2; ++c) { g0[c] = (f32x4){0.f, 0.f, 0.f, 0.f}; g1[c] = g0[c]; if (MODE >= 1) { g0[c] = *(const f32x4*)(gpost + c * 512 + lane * 8); g1[c] = *(const f32x4*)(gpost + c * 512 + lane * 8 + 4); } }
  u32x4 xa[2][4], oa[2][2]; float sq[2];
#define E0_LOAD(S_, row_) do { const size_t off_ = (size_t)(row_) * 1024 + lane * 8; \
    if (MODE <= 1) { xa[S_][0] = *(const u32x4*)(p.x + off_); xa[S_][1] = *(const u32x4*)(p.x + off_ + 4); xa[S_][2] = *(const u32x4*)(p.x + off_ + 512); xa[S_][3] = *(const u32x4*)(p.x + off_ + 516); } \
    else { xa[S_][0] = *(const u32x4*)(p.xb + off_); xa[S_][1] = *(const u32x4*)(p.xb + off_ + 512); } \
    if (MODE >= 1) { oa[S_][0] = *(const u32x4*)(p.gate + off_); oa[S_][1] = *(const u32x4*)(p.gate + off_ + 512); sq[S_] = lane < 16 ? p.ssq_out[(size_t)(row_) * 16 + lane] : 0.f; } } while (0)
#define E0_PROC(S_, row_) do { float v[2][8]; \
    _Pragma("unroll") for (int c = 0; c < 2; ++c) { \
      if (MODE <= 1) { const u32x4 a_ = xa[S_][2 * c], b_ = xa[S_][2 * c + 1]; \
        v[c][0] = __uint_as_float(a_.x); v[c][1] = __uint_as_float(a_.y); v[c][2] = __uint_as_float(a_.z); v[c][3] = __uint_as_float(a_.w); \
        v[c][4] = __uint_as_float(b_.x); v[c][5] = __uint_as_float(b_.y); v[c][6] = __uint_as_float(b_.z); v[c][7] = __uint_as_float(b_.w); } \
      else { const u32x4 u_ = xa[S_][c]; v[c][0] = bf_lo(u_.x); v[c][1] = bf_hi(u_.x); v[c][2] = bf_lo(u_.y); v[c][3] = bf_hi(u_.y); v[c][4] = bf_lo(u_.z); v[c][5] = bf_hi(u_.z); v[c][6] = bf_lo(u_.w); v[c][7] = bf_hi(u_.w); } } \
    if (MODE >= 1) { const float rso = rsqrtf(wave_sum(sq[S_]) * (1.0f / 1024.0f) + EPSV); \
      _Pragma("unroll") for (int c = 0; c < 2; ++c) { const u32x4 ob = oa[S_][c]; \
        v[c][0] += bf_lo(ob.x) * rso * g0[c][0]; v[c][1] += bf_hi(ob.x) * rso * g0[c][1]; v[c][2] += bf_lo(ob.y) * rso * g0[c][2]; v[c][3] += bf_hi(ob.y) * rso * g0[c][3]; \
        v[c][4] += bf_lo(ob.z) * rso * g1[c][0]; v[c][5] += bf_hi(ob.z) * rso * g1[c][1]; v[c][6] += bf_lo(ob.w) * rso * g1[c][2]; v[c][7] += bf_hi(ob.w) * rso * g1[c][3]; } } \
    if (MODE == 3) { _Pragma("unroll") for (int c = 0; c < 2; ++c) { const size_t off_ = (size_t)(row_) * 1024 + c * 512 + lane * 8; \
        *(f32x4*)(p.out + off_) = (f32x4){v[c][0], v[c][1], v[c][2], v[c][3]}; *(f32x4*)(p.out + off_ + 4) = (f32x4){v[c][4], v[c][5], v[c][6], v[c][7]}; } } \
    else { float ss = 0.f; \
      _Pragma("unroll") for (int c = 0; c < 2; ++c) { u32x4 u_; \
        u_.x = pk_bf16(v[c][0], v[c][1]); u_.y = pk_bf16(v[c][2], v[c][3]); u_.z = pk_bf16(v[c][4], v[c][5]); u_.w = pk_bf16(v[c][6], v[c][7]); \
        _Pragma("unroll") for (int i = 0; i < 8; ++i) ss += v[c][i] * v[c][i]; \
        *(u32x4*)(p.xb + (size_t)(row_) * 1024 + c * 512 + lane * 8) = u_; } \
      ss = wave_sum(ss); if (lane == 0) p.rs_x[row_] = rsqrtf(ss * (1.0f / 1024.0f) + EPSV); } } while (0)
  int row = blockIdx.x * 8 + w;
  if (row < NTOK) E0_LOAD(0, row);
  for (; row < NTOK; row += 2 * step) {
    const int r1 = row + step, r2 = row + 2 * step;
    if (r1 < NTOK) E0_LOAD(1, r1);
    E0_PROC(0, row);
    if (r1 < NTOK) {
      if (r2 < NTOK) E0_LOAD(0, r2);
      E0_PROC(1, r1);
    }
  }
#undef E0_LOAD
#undef E0_PROC
}

#define MFMA16(a, b, c) __builtin_amdgcn_mfma_f32_16x16x32_bf16((a), (b), (c), 0, 0, 0)
#define MFMA32(a, b, c) __builtin_amdgcn_mfma_f32_32x32x16_bf16((a), (b), (c), 0, 0, 0)
#define GSTAGE 32768

template <bool TR>
DI void gemm_core(const bf16_t* __restrict__ A, const bf16_t* __restrict__ Bt, const int K, const int row0, const int col0,
                  char* lds, f32x4 (&acc)[8][4]) {
  const int tid = get_tid(), lane = tid & 63, wid = __builtin_amdgcn_readfirstlane(tid >> 6), wr = wid >> 2, wc = wid & 3, fr = lane & 15, fq = lane >> 4;
  const unsigned voff = (unsigned)(((lane >> 2) * K + (((lane & 3) ^ ((4 - ((lane >> 4) & 3)) & 3)) << 3)) * 2);
  const char* gsrc[4];
#pragma unroll
  for (int j = 0; j < 4; ++j) {
    const int q = wid * 4 + j;
    gsrc[j] = (q < 16 ? (const char*)(A + (size_t)(row0 + q * 16) * K) : (const char*)(Bt + (size_t)(col0 + (q - 16) * 16) * K)) + voff;
  }
  LAS char* ldsl = (LAS char*)lds;
  const unsigned ldsbase = (unsigned)(size_t)ldsl;
#define G_ISSUE(kt_, st_) do { _Pragma("unroll") for (int j_ = 0; j_ < 4; ++j_) \
    __builtin_amdgcn_global_load_lds((const unsigned*)(gsrc[j_] + (size_t)(kt_) * 64), (LAS unsigned*)(ldsl + (st_) * GSTAGE + (wid * 4 + j_) * 1024), 16, 0, 0); } while (0)
#pragma unroll
  for (int m = 0; m < 8; ++m)
#pragma unroll
    for (int n = 0; n < 4; ++n) acc[m][n] = (f32x4){0.f, 0.f, 0.f, 0.f};
  const int nk = K >> 5;
  G_ISSUE(0, 0);
  G_ISSUE(1, 1);
  G_ISSUE(2, 2);
  const int gx = ((4 - (fr >> 2)) & 3);
  const int aoff = (wr * 128 + fr) * 64 + ((fq ^ gx) << 4);
  const int boff = 16384 + (wc * 64 + fr) * 64 + ((fq ^ gx) << 4);
  for (int kt = 0; kt < nk; ++kt) {
    if (kt + 2 < nk) asm volatile("s_waitcnt vmcnt(8)" ::: "memory"); else if (kt + 1 < nk) asm volatile("s_waitcnt vmcnt(4)" ::: "memory"); else asm volatile("s_waitcnt vmcnt(0)" ::: "memory");
    __builtin_amdgcn_s_barrier();
    asm volatile("" ::: "memory");
    const unsigned sa = ldsbase + (kt & 3) * GSTAGE;
    bf16x8 af[8], bfr[4];
    asm volatile("ds_read_b128 %0, %9\n\tds_read_b128 %1, %9 offset:1024\n\tds_read_b128 %2, %9 offset:2048\n\tds_read_b128 %3, %9 offset:3072\n\t"
                 "ds_read_b128 %4, %8\n\tds_read_b128 %5, %8 offset:1024\n\tds_read_b128 %6, %8 offset:2048\n\tds_read_b128 %7, %8 offset:3072"
                 : "=&v"(bfr[0]), "=&v"(bfr[1]), "=&v"(bfr[2]), "=&v"(bfr[3]), "=&v"(af[0]), "=&v"(af[1]), "=&v"(af[2]), "=&v"(af[3])
                 : "v"(sa + aoff), "v"(sa + boff) : "memory");
    if (kt + 3 < nk) G_ISSUE(kt + 3, (kt + 3) & 3);
    asm volatile("s_waitcnt lgkmcnt(0)" : "+v"(bfr[0]), "+v"(bfr[1]), "+v"(bfr[2]), "+v"(bfr[3]), "+v"(af[0]), "+v"(af[1]), "+v"(af[2]), "+v"(af[3]) : : "memory");
#pragma unroll
    for (int m = 0; m < 4; ++m)
#pragma unroll
      for (int n = 0; n < 4; ++n) acc[m][n] = TR ? MFMA16(af[m], bfr[n], acc[m][n]) : MFMA16(bfr[n], af[m], acc[m][n]);
    asm volatile("ds_read_b128 %0, %4 offset:4096\n\tds_read_b128 %1, %4 offset:5120\n\tds_read_b128 %2, %4 offset:6144\n\tds_read_b128 %3, %4 offset:7168\n\t"
                 "s_waitcnt lgkmcnt(0)"
                 : "=&v"(af[4]), "=&v"(af[5]), "=&v"(af[6]), "=&v"(af[7]) : "v"(sa + aoff) : "memory");
#pragma unroll
    for (int m = 4; m < 8; ++m)
#pragma unroll
      for (int n = 0; n < 4; ++n) acc[m][n] = TR ? MFMA16(af[m], bfr[n], acc[m][n]) : MFMA16(bfr[n], af[m], acc[m][n]);
  }
  asm volatile("" ::: "memory");
  __builtin_amdgcn_s_barrier();
#undef G_ISSUE
}

DI void rope4(const float2* rope, int pos, int fq, f32x4& t1, f32x4& t2) {
  const f32x4 cs0 = *(const f32x4*)(rope + pos * 16 + 4 * fq);
  const f32x4 cs1 = *(const f32x4*)(rope + pos * 16 + 4 * fq + 2);
  const float c[4] = {cs0[0], cs0[2], cs1[0], cs1[2]}, s[4] = {cs0[1], cs0[3], cs1[1], cs1[3]};
#pragma unroll
  for (int r = 0; r < 4; ++r) { const float a = t1[r], b = t2[r]; t1[r] = a * c[r] - b * s[r]; t2[r] = a * s[r] + b * c[r]; }
}
DI f32x4 silu4(f32x4 v) { v[0] = silu_f(v[0]); v[1] = silu_f(v[1]); v[2] = silu_f(v[2]); v[3] = silu_f(v[3]); return v; }
DI float sumsq4(f32x4 v) { return v[0] * v[0] + v[1] * v[1] + v[2] * v[2] + v[3] * v[3]; }

template <bool TR> DI void epi_put(char* wreg, int m, int n, int fr, int fq, u32x2 v) {
  if (!TR) { const int row = 16 * m + fr, ch = 2 * n + (fq >> 1); *(u32x2*)(wreg + row * 128 + ((ch ^ (row & 7)) << 4) + (fq & 1) * 8) = v; }
  else { const int row = 16 * n + fr, ch = 2 * m + (fq >> 1); *(u32x2*)(wreg + row * 256 + ((ch ^ (row & 15)) << 4) + (fq & 1) * 8) = v; }
}
template <bool TR> DI void epi_flush(const char* wreg, int lane, bf16_t* dst, size_t ld) {
#pragma unroll
  for (int j = 0; j < 16; ++j) {
    if (!TR) { const int row = 8 * j + (lane >> 3), ch = lane & 7; const u32x4 v = *(const u32x4*)(wreg + row * 128 + ((ch ^ (row & 7)) << 4)); *(u32x4*)(dst + (size_t)row * ld + ch * 8) = v; }
    else { const int row = 4 * j + (lane >> 4), ch = lane & 15; const u32x4 v = *(const u32x4*)(wreg + row * 256 + ((ch ^ (row & 15)) << 4)); *(u32x4*)(dst + (size_t)row * ld + ch * 8) = v; }
  }
}
#define LDS_BARRIER() do { asm volatile("s_waitcnt lgkmcnt(0)" ::: "memory"); __builtin_amdgcn_s_barrier(); asm volatile("" ::: "memory"); } while (0)
#define EPI_END() do { asm volatile("" ::: "memory"); __builtin_amdgcn_s_barrier(); asm volatile("" ::: "memory"); } while (0)

template <int EPI>
DI void gemm_tile(const Params& p, const int layer, const int tm, int tn, char* lds) {
  const int tid = get_tid(), lane = tid & 63, wid = __builtin_amdgcn_readfirstlane(tid >> 6), wr = wid >> 2, wc = wid & 3, fr = lane & 15, fq = lane >> 4;
  const int row0 = tm * 256, rb = row0 + wr * 128;
  const int c0 = tn * 256 + wc * 64;
  char* wreg = lds + wid * 16384;
  f32x4 acc[8][4];
  if (EPI == 1) {
    float rs[8];
#pragma unroll
    for (int m = 0; m < 8; ++m) rs[m] = p.rs_x[rb + m * 16 + fr];
    gemm_core<false>(p.xb, p.wt_a_in + (size_t)layer * 1536 * 1024, 1024, row0, tn * 256, lds, acc);
    if (c0 < 384) {
      const bool isq = c0 < 256;
      float* sq = isq ? p.ssq_cq : p.ssq_ckv; const int sld = isq ? 4 : 2, si = isq ? (c0 >> 6) : ((c0 - 256) >> 6);
#pragma unroll
      for (int m = 0; m < 8; ++m) {
        float ss = 0.f;
#pragma unroll
        for (int n = 0; n < 4; ++n) { const f32x4 v = acc[m][n] * rs[m]; ss += sumsq4(v); epi_put<false>(wreg, m, n, fr, fq, pack4(v)); }
        ss += __shfl_xor(ss, 16); ss += __shfl_xor(ss, 32);
        if (fq == 0) sq[(size_t)(rb + m * 16 + fr) * sld + si] = ss;
      }
      if (isq) epi_flush<false>(wreg, lane, p.cq + (size_t)rb * 256 + c0, 256);
      else epi_flush<false>(wreg, lane, p.ckv + (size_t)rb * 128 + (c0 - 256), 128);
    } else if (c0 < 1408) {
#pragma unroll
      for (int m = 0; m < 8; ++m)
#pragma unroll
        for (int n = 0; n < 4; ++n) epi_put<false>(wreg, m, n, fr, fq, pack4(silu4(acc[m][n] * rs[m])));
      epi_flush<false>(wreg, lane, p.gate + (size_t)rb * 1024 + (c0 - 384), 1024);
    } else if (c0 == 1408) {
#pragma unroll
      for (int m = 0; m < 8; ++m) {
        const int row = rb + m * 16 + fr;
        f32x4 t1 = acc[m][0] * rs[m], t2 = acc[m][1] * rs[m];
        rope4(p.rope, row & (SEQL - 1), fq, t1, t2);
        *(u32x2*)(p.kr + (size_t)row * 32 + 4 * fq) = pack4(t1);
        *(u32x2*)(p.kr + (size_t)row * 32 + 16 + 4 * fq) = pack4(t2);
      }
    }
    EPI_END();
  } else if (EPI == 2) {
    float rs[8];
#pragma unroll
    for (int m = 0; m < 8; ++m) { const f32x4 sq = *(const f32x4*)(p.ssq_cq + (size_t)(rb + m * 16 + fr) * 4); rs[m] = rsqrtf((sq[0] + sq[1] + sq[2] + sq[3]) * (1.0f / 256.0f) + EPSV) * QSCALE_A; }
    gemm_core<false>(p.cq, p.wt_a_uq + (size_t)layer * 1536 * 256, 256, row0, tn * 256, lds, acc);
#pragma unroll
    for (int m = 0; m < 8; ++m) {
      const int row = rb + m * 16 + fr;
#pragma unroll
      for (int n = 0; n < 4; n += 2) {
        const int cg = c0 + n * 16;
        f32x4 t1 = acc[m][n] * rs[m], t2 = acc[m][n + 1] * rs[m];
        if ((cg % 96) == 64) rope4(p.rope, row & (SEQL - 1), fq, t1, t2);
        epi_put<false>(wreg, m, n, fr, fq, pack4(t1));
        epi_put<false>(wreg, m, n + 1, fr, fq, pack4(t2));
      }
    }
    epi_flush<false>(wreg, lane, p.Q + (size_t)rb * 1536 + c0, 1536);
    EPI_END();
  } else if (EPI == 3) {
    const bf16_t* Bt = p.wt_a_ukv + (size_t)layer * 2048 * 128;
    if (tn < 4) {
      float rs[8];
#pragma unroll
      for (int m = 0; m < 8; ++m) { const float2 sq = *(const float2*)(p.ssq_ckv + (size_t)(rb + m * 16 + fr) * 2); rs[m] = rsqrtf((sq.x + sq.y) * (1.0f / 128.0f) + EPSV); }
      gemm_core<false>(p.ckv, Bt, 128, row0, tn * 256, lds, acc);
#pragma unroll
      for (int m = 0; m < 8; ++m)
#pragma unroll
        for (int n = 0; n < 4; ++n) epi_put<false>(wreg, m, n, fr, fq, pack4(acc[m][n] * rs[m]));
      epi_flush<false>(wreg, lane, p.Kb + (size_t)rb * 1024 + c0, 1024);
    } else {
      gemm_core<true>(p.ckv, Bt, 128, row0, tn * 256, lds, acc);
      const int head = (c0 - 1024) >> 6, b = row0 >> 12;
#pragma unroll
      for (int m = 0; m < 8; ++m) {
        const int rowb = rb + m * 16 + 4 * fq;
        const f32x4 s0 = *(const f32x4*)(p.ssq_ckv + (size_t)rowb * 2), s1 = *(const f32x4*)(p.ssq_ckv + (size_t)rowb * 2 + 4);
        f32x4 rs;
        rs[0] = rsqrtf((s0[0] + s0[1]) * (1.0f / 128.0f) + EPSV); rs[1] = rsqrtf((s0[2] + s0[3]) * (1.0f / 128.0f) + EPSV);
        rs[2] = rsqrtf((s1[0] + s1[1]) * (1.0f / 128.0f) + EPSV); rs[3] = rsqrtf((s1[2] + s1[3]) * (1.0f / 128.0f) + EPSV);
#pragma unroll
        for (int n = 0; n < 4; ++n) epi_put<true>(wreg, m, n, fr, fq, pack4(acc[m][n] * rs));
      }
      epi_flush<true>(wreg, lane, p.Vt + ((size_t)(b * 16 + head) * 64) * SEQL + (rb & (SEQL - 1)), SEQL);
    }
    EPI_END();
  } else if (EPI == 4) {
    const int sec = layer == 0 ? (tn >> 2) : 2 + (tn >> 2);
    const bf16_t* Bt = layer == 0 ? p.wt_b1 : p.wt_b1 + (size_t)2 * 2048 * 1024;
    const int cw = (tn & 3) * 256 + wc * 64;
    if (sec != 1) {
      float rs[8];
#pragma unroll
      for (int m = 0; m < 8; ++m) rs[m] = p.rs_x[rb + m * 16 + fr] * (sec == 2 ? QSCALE_B : 1.0f);
      gemm_core<false>(p.xb, Bt, 1024, row0, tn * 256, lds, acc);
#pragma unroll
      for (int m = 0; m < 8; ++m)
#pragma unroll
        for (int n = 0; n < 4; ++n) { f32x4 v = acc[m][n] * rs[m]; if (sec == 3) v = silu4(v); epi_put<false>(wreg, m, n, fr, fq, pack4(v)); }
      epi_flush<false>(wreg, lane, (sec == 0 ? p.Kb : sec == 2 ? p.Q : p.gate) + (size_t)rb * 1024 + cw, 1024);
    } else {
      gemm_core<true>(p.xb, Bt, 1024, row0, tn * 256, lds, acc);
      const int b = row0 >> 12, h = cw >> 6;
#pragma unroll
      for (int m = 0; m < 8; ++m) {
        const f32x4 rs = *(const f32x4*)(p.rs_x + rb + m * 16 + 4 * fq);
#pragma unroll
        for (int n = 0; n < 4; ++n) epi_put<true>(wreg, m, n, fr, fq, pack4(acc[m][n] * rs));
      }
      epi_flush<true>(wreg, lane, p.Vt + ((size_t)(b * 16 + h) * 64) * SEQL + (rb & (SEQL - 1)), SEQL);
    }
    EPI_END();
  } else {
    const bf16_t* Bt = layer < 2 ? p.wt_a_o + (size_t)layer * 1024 * 1024 : p.wt_b_o + (size_t)(layer - 2) * 1024 * 1024;
    gemm_core<false>(p.og, Bt, 1024, row0, tn * 256, lds, acc);
#pragma unroll
    for (int m = 0; m < 8; ++m) {
      float ss = 0.f;
#pragma unroll
      for (int n = 0; n < 4; ++n) { const f32x4 v = acc[m][n]; ss += sumsq4(v); epi_put<false>(wreg, m, n, fr, fq, pack4(v)); }
      ss += __shfl_xor(ss, 16); ss += __shfl_xor(ss, 32);
      if (fq == 0) p.ssq_out[(size_t)(rb + m * 16 + fr) * 16 + (c0 >> 6)] = ss;
    }
    epi_flush<false>(wreg, lane, p.gate + (size_t)rb * 1024 + c0, 1024);
    EPI_END();
  }
}

template <int EPI>
DI void gemm_phase(const Params& p, const int layer, char* lds) {
  const int nN = EPI == 1 ? 6 : EPI == 23 ? 14 : EPI == 4 ? (layer == 0 ? 16 : 8) : 4;
  const int U = 128 * nN;
  for (int L = blockIdx.x; L < U; L += gridDim.x) {
    const int u = (L & 7) * (U >> 3) + (L >> 3);
    const int tm = u / nN, tn = u % nN;
    if (EPI == 23) { if (tn < 6) gemm_tile<2>(p, layer, tm, tn, lds); else gemm_tile<3>(p, layer, tm, tn - 6, lds); }
    else gemm_tile<(EPI == 23 ? 2 : EPI)>(p, layer, tm, tn, lds);
  }
}


DI void attn_store(const Params& p, char* wreg, const f32x16& o0, const f32x16& o1, float inv, size_t tokbase  , int h, int lane) {
  const int r = lane & 31, hh = lane >> 5;
  u32x4 gw[4];
#pragma unroll
  for (int j = 0; j < 4; ++j) gw[j] = *(const u32x4*)(p.gate + (tokbase + 8 * j + (lane >> 3)) * 1024 + h * 64 + (lane & 7) * 8);
#pragma unroll
  for (int dt = 0; dt < 2; ++dt) {
    const f32x16& ov = dt ? o1 : o0;
#pragma unroll
    for (int g = 0; g < 4; ++g) {
      const int c16 = dt * 8 + 2 * g + hh;
      *(f32x4*)(wreg + r * 256 + ((c16 ^ (r & 15)) << 4)) = (f32x4){ov[4 * g] * inv, ov[4 * g + 1] * inv, ov[4 * g + 2] * inv, ov[4 * g + 3] * inv};
    }
  }
#pragma unroll
  for (int j = 0; j < 4; ++j) {
    const int row = 8 * j + (lane >> 3), cp = lane & 7;
    const f32x4 a = *(const f32x4*)(wreg + row * 256 + (((2 * cp) ^ (row & 15)) << 4));
    const f32x4 b = *(const f32x4*)(wreg + row * 256 + (((2 * cp + 1) ^ (row & 15)) << 4));
    const size_t off = (tokbase + row) * 1024 + h * 64 + cp * 8;
    u32x4 w;
    w.x = pk_bf16(a[0] * bf_lo(gw[j].x), a[1] * bf_hi(gw[j].x)); w.y = pk_bf16(a[2] * bf_lo(gw[j].y), a[3] * bf_hi(gw[j].y));
    w.z = pk_bf16(b[0] * bf_lo(gw[j].z), b[1] * bf_hi(gw[j].z)); w.w = pk_bf16(b[2] * bf_lo(gw[j].w), b[3] * bf_hi(gw[j].w));
    *(u32x4*)(p.og + off) = w;
  }
}

DI void sb_phase(const Params& p, char* lds, unsigned* sflags) {
  const int tid = get_tid(), lane = tid & 63, w = tid >> 6, r = lane & 31, hh = lane >> 5;
  const int g = blockIdx.x & 7, nb = gridDim.x >> 3;
  const int klo = (tid >> 3) * 128 + (((tid & 7) ^ ((tid >> 4) & 7)) << 4);
  const int vlo = 8192 + (tid >> 3) * 128 + ((((tid & 6)) ^ ((tid >> 4) & 7)) << 4) + (tid & 1) * 8;
  const int ksw0 = (r >> 1) & 7, vsw = (r >> 1) & 7;
#define SB_LOAD(X_, KR_, VR_) do { KR_ = *(const u32x4*)(kp + (size_t)((X_) * 64) * 1024); VR_ = *(const u32x4*)(vp + (X_) * 64); } while (0)
#define SB_WRITE(X_, KR_, VR_) do { char* base_ = lds + ((X_) & 7) * 16384; *(u32x4*)(base_ + klo) = KR_; \
    u32x2 lo_, hi_; lo_.x = VR_.x; lo_.y = VR_.y; hi_.x = VR_.z; hi_.y = VR_.w; *(u32x2*)(base_ + vlo) = lo_; *(u32x2*)(base_ + (vlo ^ 16)) = hi_; } while (0)
#define SB_COORDS(l_) const int bh_ = g + 8 * ((l_) >> 4), b = bh_ >> 4, h = bh_ & 15, qb = 15 - (((l_) + ((l_) >> 5)) & 15); \
    const size_t tok0 = (size_t)b * SEQL; const int q0 = qb * 256, qrow = q0 + 32 * w + r, T0 = 4 * qb; \
    const bf16_t* kp = p.Kb + (tok0 + (tid >> 3)) * 1024 + h * 64 + (tid & 7) * 8; \
    const bf16_t* vp = p.Vt + ((size_t)(b * 16 + h) * 64 + (tid >> 3)) * SEQL + (tid & 7) * 8;
#define SB_PREFETCH_UNIT() do { const bf16_t* Qp = p.Q + (tok0 + qrow) * 1024 + h * 64 + 8 * hh; \
    _Pragma("unroll") for (int s_ = 0; s_ < 4; ++s_) qf[s_] = *(const bf16x8*)(Qp + 16 * s_); \
    _Pragma("unroll") for (int i_ = 0; i_ < 4; ++i_) SB_LOAD(T0 + i_, k4[i_], v4[i_]); } while (0)
  bf16x8 qf[4]; u32x4 k4[4], v4[4];
  int l = blockIdx.x >> 3;
  if (l >= 256) return;
  { SB_COORDS(l); SB_PREFETCH_UNIT(); }
  for (; l < 256; l += nb) {
    SB_COORDS(l);
#pragma unroll
    for (int i = 0; i < 4; ++i) SB_WRITE(T0 + i, k4[i], v4[i]);
#pragma unroll
    for (int i = 0; i < 4; ++i) if (T0 - 4 + i >= 0) SB_LOAD(T0 - 4 + i, k4[i], v4[i]);
    __syncthreads();
    u32x4 kreg, vreg;
    f32x16 o0, o1;
#pragma unroll
    for (int i = 0; i < 16; ++i) { o0[i] = 0.f; o1[i] = 0.f; }
    float carry = 1.0f;
    bool done_w = false;
    for (int s = 0;; ++s) {
      const int L = T0 - s - 1;
      if (s >= 4 && L >= 0) SB_LOAD(L, kreg, vreg);
      const int X = T0 + (w >> 1) - s;
      if (X < 0) done_w = true;
      if (!done_w) {
        const int k0 = X * 64;
        const char* kb = lds + (X & 7) * 16384; const char* vb = kb + 8192;
        const bool live1 = k0 + 32 < q0 + 32 * w + 31;
        f32x16 s0, s1;
#pragma unroll
        for (int i = 0; i < 16; ++i) { s0[i] = 0.f; s1[i] = 0.f; }
#pragma unroll
        for (int ks = 0; ks < 4; ++ks) {
          const int co = ((2 * ks + hh) ^ ksw0) << 4;
          const bf16x8 k0f = *(const bf16x8*)(kb + r * 128 + co);
          s0 = MFMA32(k0f, qf[ks], s0);
          if (live1) { const bf16x8 k1f = *(const bf16x8*)(kb + (32 + r) * 128 + co); s1 = MFMA32(k1f, qf[ks], s1); }
        }
        const int kbase = k0 + 4 * hh;
        const bool need_mask = k0 + 63 >= q0 + 32 * w;
        bool act[2] = {false, false};
#pragma unroll
        for (int kt = 1; kt >= 0; --kt) {
          if ((kt == 1 && !live1) || done_w) continue;
          act[kt] = true;
          f32x16& sv = kt ? s1 : s0;
          float om[16];
#pragma unroll
          for (int i = 0; i < 16; ++i) {
            const float z = sv[i];
            const float e = __builtin_amdgcn_exp2f(-fmaxf(z, -126.0f));
            float be = __builtin_amdgcn_rcpf(1.0f + e);
            float o_ = e * be;
            if (need_mask) { const int key = kbase + 32 * kt + (i & 3) + 8 * (i >> 2); if (key >= qrow) { be = 0.f; o_ = 1.f; } }
            sv[i] = be; om[i] = o_;
          }
          float G[4], Go[4];
#pragma unroll
          for (int m = 0; m < 4; ++m) { G[m] = (om[4 * m] * om[4 * m + 1]) * (om[4 * m + 2] * om[4 * m + 3]); Go[m] = __shfl_xor(G[m], 32); }
          float run = carry;
#pragma unroll
          for (int m = 3; m >= 0; --m) {
            float a = hh == 0 ? run * Go[m] : run;
            sv[4 * m + 3] *= a; a *= om[4 * m + 3];
            sv[4 * m + 2] *= a; a *= om[4 * m + 2];
            sv[4 * m + 1] *= a; a *= om[4 * m + 1];
            sv[4 * m + 0] *= a;
            run *= G[m] * Go[m];
          }
          carry = run;
          done_w = __all(carry < SB_DONE_THR);
        }
        if (act[0]) {
          bf16x8 pf0, pf1; u32x4 t;
          t.x = pk_bf16(s0[0], s0[1]); t.y = pk_bf16(s0[2], s0[3]); t.z = pk_bf16(s0[4], s0[5]); t.w = pk_bf16(s0[6], s0[7]); pf0 = __builtin_bit_cast(bf16x8, t);
          t.x = pk_bf16(s0[8], s0[9]); t.y = pk_bf16(s0[10], s0[11]); t.z = pk_bf16(s0[12], s0[13]); t.w = pk_bf16(s0[14], s0[15]); pf1 = __builtin_bit_cast(bf16x8, t);
          const int c0 = ((0 + hh) ^ vsw) << 4, c1 = ((2 + hh) ^ vsw) << 4;
          o0 = MFMA32(*(const bf16x8*)(vb + r * 128 + c0), pf0, o0); o1 = MFMA32(*(const bf16x8*)(vb + (32 + r) * 128 + c0), pf0, o1);
          o0 = MFMA32(*(const bf16x8*)(vb + r * 128 + c1), pf1, o0); o1 = MFMA32(*(const bf16x8*)(vb + (32 + r) * 128 + c1), pf1, o1);
        }
        if (act[1]) {
          bf16x8 pf2, pf3; u32x4 t;
          t.x = pk_bf16(s1[0], s1[1]); t.y = pk_bf16(s1[2], s1[3]); t.z = pk_bf16(s1[4], s1[5]); t.w = pk_bf16(s1[6], s1[7]); pf2 = __builtin_bit_cast(bf16x8, t);
          t.x = pk_bf16(s1[8], s1[9]); t.y = pk_bf16(s1[10], s1[11]); t.z = pk_bf16(s1[12], s1[13]); t.w = pk_bf16(s1[14], s1[15]); pf3 = __builtin_bit_cast(bf16x8, t);
          const int c2 = ((4 + hh) ^ vsw) << 4, c3 = ((6 + hh) ^ vsw) << 4;
          o0 = MFMA32(*(const bf16x8*)(vb + r * 128 + c2), pf2, o0); o1 = MFMA32(*(const bf16x8*)(vb + (32 + r) * 128 + c2), pf2, o1);
          o0 = MFMA32(*(const bf16x8*)(vb + r * 128 + c3), pf3, o0); o1 = MFMA32(*(const bf16x8*)(vb + (32 + r) * 128 + c3), pf3, o1);
        }
      }
      if (lane == 0) sflags[(s & 1) * 8 + w] = done_w ? 1u : 0u;
      if (s == 0) {
#pragma unroll
        for (int i = 0; i < 4; ++i) if (T0 - 4 + i >= 0) SB_WRITE(T0 - 4 + i, k4[i], v4[i]);
      } else if (s >= 4 && L >= 0) SB_WRITE(L, kreg, vreg);
      __syncthreads();
      { const unsigned* f = sflags + (s & 1) * 8; if (f[0] & f[1] & f[2] & f[3] & f[4] & f[5] & f[6] & f[7]) break; }
    }
    if (l + nb < 256) {
      const int ln = l + nb;
      const int bhn = g + 8 * (ln >> 4), bn = bhn >> 4, hn = bhn & 15, qbn = 15 - ((ln + (ln >> 5)) & 15);
      const size_t tokn = (size_t)bn * SEQL; const int qrown = qbn * 256 + 32 * w + r, T0n = 4 * qbn;
      const bf16_t* Qp = p.Q + (tokn + qrown) * 1024 + hn * 64 + 8 * hh;
#pragma unroll
      for (int s_ = 0; s_ < 4; ++s_) qf[s_] = *(const bf16x8*)(Qp + 16 * s_);
      const bf16_t* kpn = p.Kb + (tokn + (tid >> 3)) * 1024 + hn * 64 + (tid & 7) * 8;
      const bf16_t* vpn = p.Vt + ((size_t)(bn * 16 + hn) * 64 + (tid >> 3)) * SEQL + (tid & 7) * 8;
#pragma unroll
      for (int i = 0; i < 4; ++i) { k4[i] = *(const u32x4*)(kpn + (size_t)((T0n + i) * 64) * 1024); v4[i] = *(const u32x4*)(vpn + (T0n + i) * 64); }
    }
    attn_store(p, lds + w * 8192, o0, o1, 1.0f, tok0 + q0 + 32 * w, h, lane);
    LDS_BARRIER();
  }
#undef SB_LOAD
#undef SB_WRITE
#undef SB_COORDS
#undef SB_PREFETCH_UNIT
}

DI void mla_qk(const char* kb, const bf16x8 (&qf)[6], const bf16x8 onek, const bf16x8 bias, int r, int hh, int ksw, f32x16& s0, f32x16& s1) {
  const unsigned a0 = (unsigned)(size_t)(LAS const char*)kb + r * 256, a1 = a0 + 32 * 256;
  unsigned co[6];
#pragma unroll
  for (int ks = 0; ks < 6; ++ks) co[ks] = ((2 * ks + hh) ^ ksw) << 4;
#pragma unroll
  for (int i = 0; i < 16; ++i) { s0[i] = 0.f; s1[i] = 0.f; }
  bf16x8 kf[6];
  asm volatile("ds_read_b128 %0, %6\n\tds_read_b128 %1, %7\n\tds_read_b128 %2, %8\n\tds_read_b128 %3, %9\n\tds_read_b128 %4, %10\n\tds_read_b128 %5, %11"
               : "=&v"(kf[0]), "=&v"(kf[1]), "=&v"(kf[2]), "=&v"(kf[3]), "=&v"(kf[4]), "=&v"(kf[5])
               : "v"(a0 + co[0]), "v"(a1 + co[0]), "v"(a0 + co[1]), "v"(a1 + co[1]), "v"(a0 + co[2]), "v"(a1 + co[2]) : "memory");
  s0 = MFMA32(onek, bias, s0);
  s1 = MFMA32(onek, bias, s1);
  asm volatile("s_waitcnt lgkmcnt(0)" : "+v"(kf[0]), "+v"(kf[1]), "+v"(kf[2]), "+v"(kf[3]), "+v"(kf[4]), "+v"(kf[5]) : : "memory");
#pragma unroll
  for (int k3 = 0; k3 < 3; ++k3) { s0 = MFMA32(kf[2 * k3], qf[k3], s0); s1 = MFMA32(kf[2 * k3 + 1], qf[k3], s1); }
  bf16x8 kg[6];
  asm volatile("ds_read_b128 %0, %6\n\tds_read_b128 %1, %7\n\tds_read_b128 %2, %8\n\tds_read_b128 %3, %9\n\tds_read_b128 %4, %10\n\tds_read_b128 %5, %11\n\t"
               "s_waitcnt lgkmcnt(0)"
               : "=&v"(kg[0]), "=&v"(kg[1]), "=&v"(kg[2]), "=&v"(kg[3]), "=&v"(kg[4]), "=&v"(kg[5])
               : "v"(a0 + co[3]), "v"(a1 + co[3]), "v"(a0 + co[4]), "v"(a1 + co[4]), "v"(a0 + co[5]), "v"(a1 + co[5]) : "memory");
#pragma unroll
  for (int k3 = 0; k3 < 3; ++k3) { s0 = MFMA32(kg[2 * k3], qf[3 + k3], s0); s1 = MFMA32(kg[2 * k3 + 1], qf[3 + k3], s1); }
}
DI void mla_mask(f32x16& s0, f32x16& s1, int kbase, int qrow) {
#pragma unroll
  for (int i = 0; i < 16; ++i) {
    const int key = kbase + (i & 3) + 8 * (i >> 2);
    if (key > qrow) s0[i] = -INFINITY;
    if (key + 32 > qrow) s1[i] = -INFINITY;
  }
}
DI bf16x8 mla_bias_frag(float m_run, int hh) {
  u32x4 t; t.x = hh == 0 ? (__float_as_uint(-m_run) >> 16) : 0u; t.y = 0u; t.z = 0u; t.w = 0u;
  return __builtin_bit_cast(bf16x8, t);
}
DI float mla_softmax_pv(f32x16& s0, f32x16& s1, f32x16& o0, f32x16& o1, f32x16& lacc, float& m_run, bf16x8& bias, const bf16x8 ones,
                        const char* vb, int r, int hh, int vsw, bool first) {
  float mx = fmaxf(fmaxf(s0[0], s0[1]), s0[2]);
#pragma unroll
  for (int i = 3; i < 15; i += 2) mx = fmaxf(fmaxf(mx, s0[i]), s0[i + 1]);
  mx = fmaxf(mx, s0[15]);
#pragma unroll
  for (int i = 0; i < 16; i += 2) mx = fmaxf(fmaxf(mx, s1[i]), s1[i + 1]);
  float delta = 0.f;
  if (__any(first || mx > 8.0f)) {
    mx = fmaxf(mx, __shfl_xor(mx, 32));
    const bool upd = (first && mx > -1e30f) || mx > 8.0f;
    if (upd) { const float m_new = __uint_as_float(pk_bf16(m_run + mx, 0.f) << 16); delta = m_new - m_run; m_run = m_new; }
    const float alpha = __builtin_amdgcn_exp2f(-delta);
    s0 = s0 - delta; s1 = s1 - delta;
    o0 = o0 * alpha; o1 = o1 * alpha; lacc = lacc * alpha;
    bias = mla_bias_frag(m_run, hh);
  }
#pragma unroll
  for (int i = 0; i < 16; ++i) { s0[i] = __builtin_amdgcn_exp2f(s0[i]); s1[i] = __builtin_amdgcn_exp2f(s1[i]); }
#pragma unroll
  for (int i = 0; i < 16; ++i) lacc[i] += s0[i] + s1[i];
  bf16x8 pf[4];
  {
    u32x4 t4;
    t4.x = pk_bf16(s0[0], s0[1]); t4.y = pk_bf16(s0[2], s0[3]); t4.z = pk_bf16(s0[4], s0[5]); t4.w = pk_bf16(s0[6], s0[7]); pf[0] = __builtin_bit_cast(bf16x8, t4);
    t4.x = pk_bf16(s0[8], s0[9]); t4.y = pk_bf16(s0[10], s0[11]); t4.z = pk_bf16(s0[12], s0[13]); t4.w = pk_bf16(s0[14], s0[15]); pf[1] = __builtin_bit_cast(bf16x8, t4);
    t4.x = pk_bf16(s1[0], s1[1]); t4.y = pk_bf16(s1[2], s1[3]); t4.z = pk_bf16(s1[4], s1[5]); t4.w = pk_bf16(s1[6], s1[7]); pf[2] = __builtin_bit_cast(bf16x8, t4);
    t4.x = pk_bf16(s1[8], s1[9]); t4.y = pk_bf16(s1[10], s1[11]); t4.z = pk_bf16(s1[12], s1[13]); t4.w = pk_bf16(s1[14], s1[15]); pf[3] = __builtin_bit_cast(bf16x8, t4);
  }
#pragma unroll
  for (int s4 = 0; s4 < 4; ++s4) {
    const int c0 = ((2 * s4 + hh) ^ vsw) << 4;
    o0 = MFMA32(*(const bf16x8*)(vb + r * 128 + c0), pf[s4], o0);
    o1 = MFMA32(*(const bf16x8*)(vb + (32 + r) * 128 + c0), pf[s4], o1);
  }
  return delta;
}

DI void mla_unit(const Params& p, const int b, const int h, const int qb, char* lds) {
  const int tid = get_tid(), lane = tid & 63, w = tid >> 6, r = lane & 31, hh = lane >> 5;
  const int q0 = qb * 256, qrow = q0 + 32 * w + r;
  const size_t tok0 = (size_t)b * SEQL;
  bf16x8 qf[6];
  {
    const bf16_t* Qp = p.Q + (tok0 + qrow) * 1536 + h * 96 + 8 * hh;
#pragma unroll
    for (int s = 0; s < 6; ++s) qf[s] = *(const bf16x8*)(Qp + 16 * s);
  }
  const bf16_t* Vg = p.Vt + ((size_t)(b * 16 + h) * 64) * SEQL;
  const bf16_t* kpn = p.Kb + (tok0 + (tid >> 3)) * 1024 + h * 64 + (tid & 7) * 8;
  const bf16_t* kpr = p.kr + (tok0 + ((tid & 255) >> 2)) * 32 + (tid & 3) * 8;
  const bf16_t* vp = Vg + (size_t)(tid >> 3) * SEQL + (tid & 7) * 8;
  const int klo_n = (tid >> 3) * 256 + (((tid & 7) ^ ((tid >> 3) & 15)) << 4);
  const int klo_r = ((tid & 255) >> 2) * 256 + (((8 + (tid & 3)) ^ (((tid & 255) >> 2) & 15)) << 4);
  const int vlo0 = 32768 + (tid >> 3) * 128 + ((((tid & 6)) ^ ((tid >> 4) & 7)) << 4) + (tid & 1) * 8;
  const bool has_r = tid < 256;
  u32x4 kreg[2], vreg[1];
#define M_KLOAD(t_) do { kreg[0] = *(const u32x4*)(kpn + (size_t)((t_) * 64) * 1024); if (has_r) kreg[1] = *(const u32x4*)(kpr + (size_t)((t_) * 64) * 32); } while (0)
#define M_VLOAD(t_) do { vreg[0] = *(const u32x4*)(vp + (t_) * 64); } while (0)
#define M_KWRITE(buf_) do { *(u32x4*)(lds + (buf_) * 16384 + klo_n) = kreg[0]; if (has_r) *(u32x4*)(lds + (buf_) * 16384 + klo_r) = kreg[1]; } while (0)
#define M_VWRITE(buf_) do { u32x2 lo_, hi_; lo_.x = vreg[0].x; lo_.y = vreg[0].y; hi_.x = vreg[0].z; hi_.y = vreg[0].w; \
      *(u32x2*)(lds + (buf_) * 8192 + vlo0) = lo_; *(u32x2*)(lds + (buf_) * 8192 + (vlo0 ^ 16)) = hi_; } while (0)
  const int n = 4 * qb + 4;
  const int nw = 4 * qb + 1 + (w >> 1);
  const int ksw = r & 15, vsw = (r >> 1) & 7;
  f32x16 o0, o1;
#pragma unroll
  for (int i = 0; i < 16; ++i) { o0[i] = 0.f; o1[i] = 0.f; }
  f32x16 lacc;
#pragma unroll
  for (int i = 0; i < 16; ++i) lacc[i] = 0.f;
  float m_run = 0.f;
  bf16x8 bias = mla_bias_frag(0.f, hh), onek, ones;
  { u32x4 t; t.x = hh == 0 ? 0x3F80u : 0u; t.y = 0u; t.z = 0u; t.w = 0u; onek = __builtin_bit_cast(bf16x8, t); t.x = 0x3F803F80u; t.y = t.x; t.z = t.x; t.w = t.x; ones = __builtin_bit_cast(bf16x8, t); }
  {
    u32x4 k1n, k1r;
    M_KLOAD(0); M_VLOAD(0);
    k1n = *(const u32x4*)(kpn + (size_t)64 * 1024); if (has_r) k1r = *(const u32x4*)(kpr + (size_t)64 * 32);
    M_KWRITE(0); M_VWRITE(0);
    *(u32x4*)(lds + 16384 + klo_n) = k1n; if (has_r) *(u32x4*)(lds + 16384 + klo_r) = k1r;
  }
  __syncthreads();
  if (w >= 4) __builtin_amdgcn_s_setprio(1);
  f32x16 sc0, sc1;
  mla_qk(lds, qf, onek, bias, r, hh, ksw, sc0, sc1);
  if (63 > q0 + 32 * w) mla_mask(sc0, sc1, 4 * hh, qrow);
  for (int idx = 0; idx < n; ++idx) {
    const char* vb = lds + 32768 + (idx & 1) * 8192;
    if (idx + 1 < nw) {
      f32x16 sn0, sn1;
      mla_qk(lds + ((idx + 1) & 1) * 16384, qf, onek, bias, r, hh, ksw, sn0, sn1);
      if (idx + 2 < n) M_KLOAD(idx + 2);
      if (idx + 1 < n) M_VLOAD(idx + 1);
      const float dl = mla_softmax_pv(sc0, sc1, o0, o1, lacc, m_run, bias, ones, vb, r, hh, vsw, idx == 0);
      if (__any(dl != 0.f)) { sn0 = sn0 - dl; sn1 = sn1 - dl; }
      if ((idx + 1) * 64 + 63 > q0 + 32 * w) mla_mask(sn0, sn1, (idx + 1) * 64 + 4 * hh, qrow);
      sc0 = sn0; sc1 = sn1;
    } else {
      if (idx + 2 < n) M_KLOAD(idx + 2);
      if (idx + 1 < n) M_VLOAD(idx + 1);
      if (idx < nw) (void)mla_softmax_pv(sc0, sc1, o0, o1, lacc, m_run, bias, ones, vb, r, hh, vsw, idx == 0);
    }
    if (idx + 2 < n) M_KWRITE(idx & 1);
    if (idx + 1 < n) M_VWRITE((idx + 1) & 1);
    __syncthreads();
  }
#undef M_KLOAD
#undef M_VLOAD
#undef M_KWRITE
#undef M_VWRITE
  __builtin_amdgcn_s_setprio(0);
  float lsum = 0.f;
#pragma unroll
  for (int i = 0; i < 16; ++i) lsum += lacc[i];
  const float inv = 1.0f / (lsum + __shfl_xor(lsum, 32));
  attn_store(p, lds + w * 8192, o0, o1, inv, tok0 + q0 + 32 * w, h, lane);
}

template <bool SB>
DI void attn_phase(const Params& p, const int slot, char* lds, unsigned* sflags, int* s_unit) {
  const int grp0 = blockIdx.x & 7;
  for (int j = 0; j < 8; ++j) {
    const int g = (grp0 + j) & 7;
    if (threadIdx.x == 0) *s_unit = (int)atomicAdd(p.counters + slot * 8 + g, 1u);
    __syncthreads();
    int l = *s_unit;
    __syncthreads();
    while (l < 256) {
      int nxt = 0;
      if (threadIdx.x == 0) nxt = (int)atomicAdd(p.counters + slot * 8 + g, 1u);
      const int bh = g + 8 * (l & 15), qb = 15 - (l >> 4);
      mla_unit(p, bh >> 4, bh & 15, qb, lds);
      if (threadIdx.x == 0) *s_unit = nxt;
      __syncthreads();
      l = *s_unit;
      __syncthreads();
    }
  }
}

__global__ void __launch_bounds__(512, 2) mk_fwd(Params p, int ph_lo, int ph_hi) {
  __shared__ __attribute__((aligned(16))) char lds[4 * GSTAGE];
  __shared__ unsigned sflags[16];
  __shared__ int s_unit;
  __shared__ uint4 xb_words;
  if (threadIdx.x == 0) xb_words = make_uint4(0u, 0u, 0u, 0u);
  __syncthreads();
  (void)xcd_barrier_post(p.bar, (volatile LAS unsigned*)&xb_words);
#ifndef PROBE_REP
#define PROBE_REP 0
#endif
#define GRID_BARRIER() do { if (ph_hi > 1000) cg::this_grid().sync();   \
    else { XcdBarrier xb; xb.bar = p.bar; xb.x = xb_xcc_id(); xb.st = (volatile LAS unsigned*)&xb_words; xcd_barrier(xb); } } while (0)
#define RUN_PHASE(type_, last_, ...) do { const int nrep_ = ((PROBE_REP >> (type_)) & 1) ? 2 : 1; \
    for (int rep = 0; rep < nrep_; ++rep) { __VA_ARGS__; if (rep + 1 < nrep_) GRID_BARRIER(); } if (!(last_)) GRID_BARRIER(); } while (0)
  RUN_PHASE(0, false, conv_phase(p, lds); rope_phase(p); e0_phase<0>(p, nullptr));
  for (int layer = 0; layer < 2; ++layer) {
    RUN_PHASE(1, false, gemm_phase<1>(p, layer, lds));
    RUN_PHASE(2, false, gemm_phase<23>(p, layer, lds));
    RUN_PHASE(3, false, attn_phase<false>(p, layer + 4 * rep, lds, sflags, &s_unit));
    RUN_PHASE(4, false, gemm_phase<5>(p, layer, lds));
    if (layer == 0) RUN_PHASE(5, false, e0_phase<1>(p, p.a_norm_post));
    else RUN_PHASE(5, false, e0_phase<2>(p, p.a_norm_post + 1024));
  }
  for (int layer = 0; layer < 2; ++layer) {
    RUN_PHASE(6, false, gemm_phase<4>(p, layer, lds));
    RUN_PHASE(7, false, sb_phase(p, lds, sflags));
    RUN_PHASE(4, false, gemm_phase<5>(p, 2 + layer, lds));
    if (layer == 0) RUN_PHASE(5, false, e0_phase<2>(p, p.b_norm_post));
    else RUN_PHASE(5, true, e0_phase<3>(p, p.b_norm_post + 1024));
  }
}

extern "C" void kernel_launch(void* const* d_in, const int* in_sizes, int n_in, void* d_out, int out_size, void* d_ws, size_t ws_size, hipStream_t stream) {
  (void)in_sizes; (void)n_in; (void)out_size;
  Params p{};
  p.x = (const float*)d_in[0]; p.a_norm_pre = (const float*)d_in[1]; p.a_w_in = (const float*)d_in[2]; p.a_q_norm = (const float*)d_in[3];
  p.a_w_uq = (const float*)d_in[4]; p.a_kv_norm = (const float*)d_in[5]; p.a_w_ukv = (const float*)d_in[6]; p.a_w_o = (const float*)d_in[7];
  p.a_norm_post = (const float*)d_in[8]; p.b_kv_norm = (const float*)d_in[9]; p.b_w_kv = (const float*)d_in[10]; p.b_norm_pre = (const float*)d_in[11];
  p.b_w_in = (const float*)d_in[12]; p.b_w_o = (const float*)d_in[13]; p.b_norm_post = (const float*)d_in[14];
  p.out = (float*)d_out;
  char* w = (char*)d_ws; size_t off = 0;
  auto take = [&](size_t bytes) { char* r = w + off; off += (bytes + 255) & ~(size_t)255; return r; };
  p.wt_a_in = (bf16_t*)take((size_t)2 * 1536 * 1024 * 2);
  p.wt_a_uq = (bf16_t*)take((size_t)2 * 1536 * 256 * 2);
  p.wt_a_ukv = (bf16_t*)take((size_t)2 * 2048 * 128 * 2);
  p.wt_a_o = (bf16_t*)take((size_t)2 * 1024 * 1024 * 2);
  p.wt_b1 = (bf16_t*)take((size_t)3 * 2048 * 1024 * 2);
  p.wt_b_o = (bf16_t*)take((size_t)2 * 1024 * 1024 * 2);
  p.xb = (bf16_t*)take((size_t)NTOK * 1024 * 2);
  p.cq = (bf16_t*)take((size_t)NTOK * 256 * 2);
  p.ckv = (bf16_t*)take((size_t)NTOK * 128 * 2);
  p.gate = (bf16_t*)take((size_t)NTOK * 1024 * 2);
  p.Q = (bf16_t*)take((size_t)NTOK * 1536 * 2);
  p.Kb = (bf16_t*)take((size_t)NTOK * 1024 * 2);
  p.og = (bf16_t*)take((size_t)NTOK * 1024 * 2);
  p.Vt = (bf16_t*)take((size_t)NTOK * 1024 * 2);
  p.kr = (bf16_t*)take((size_t)NTOK * 32 * 2);
  p.rs_x = (float*)take((size_t)NTOK * 4);
  p.ssq_cq = (float*)take((size_t)NTOK * 4 * 4);
  p.ssq_ckv = (float*)take((size_t)NTOK * 2 * 4);
  p.ssq_out = (float*)take((size_t)NTOK * 16 * 4);
  p.rope = (float2*)take((size_t)SEQL * 16 * 8);
  p.bar = (unsigned*)take((size_t)XCD_BAR_WORDS * 4 + 256);
  p.counters = p.bar + XCD_BAR_WORDS;
  if (off > ws_size) { fprintf(stderr, "workspace too small: need %zu have %zu\n", off, ws_size); return; }
  static int grid_blocks = 0;
  if (!grid_blocks) {
    int dev = 0, cus = 0, per_cu = 0;
    hipGetDevice(&dev);
    hipDeviceGetAttribute(&cus, hipDeviceAttributeMultiprocessorCount, dev);
    hipOccupancyMaxActiveBlocksPerMultiprocessor(&per_cu, mk_fwd, 512, 0);
    if (per_cu < 1) per_cu = 1;
    if (per_cu > 1) per_cu = 1;
    grid_blocks = cus * per_cu;
  }
  hipMemsetAsync(p.bar, 0, (size_t)XCD_BAR_WORDS * 4 + 256, stream);
  int lo = 0, hi = NPHASE;
  void* args[] = {&p, &lo, &hi};
  hipError_t e = hipLaunchCooperativeKernel((void*)mk_fwd, dim3(grid_blocks), dim3(512), args, 0, stream);
  if (e != hipSuccess) fprintf(stderr, "cooperative launch failed: %s (grid %d)\n", hipGetErrorString(e), grid_blocks);
}
```

```cpp
#include <hip/hip_runtime.h>
#include <hip/hip_cooperative_groups.h>
#include <cstdio>
#include <cstdint>
namespace cg = cooperative_groups;

#ifndef ONE_LAUNCH
#define ONE_LAUNCH 1
#endif

typedef unsigned short bf16_t;
typedef short bf16x8 __attribute__((ext_vector_type(8)));
typedef short s16x4 __attribute__((ext_vector_type(4)));
typedef float f32x4 __attribute__((ext_vector_type(4)));
typedef float f32x16 __attribute__((ext_vector_type(16)));
typedef unsigned u32x4 __attribute__((ext_vector_type(4)));
typedef unsigned u32x2 __attribute__((ext_vector_type(2)));

#define DI __device__ __forceinline__
#define NTOK 32768
#define SEQL 4096
#define EPSV 1e-6f
#define NPHASE 19
#define LOG2E 1.4426950408889634f
#define QSCALE_A (0.10206207261596577f * LOG2E)
#define QSCALE_B (0.125f * LOG2E)
#define SB_DONE_THR 1e-20f

struct Params {
  const float* x; const float* a_norm_pre; const float* a_w_in; const float* a_q_norm; const float* a_w_uq;
  const float* a_kv_norm; const float* a_w_ukv; const float* a_w_o; const float* a_norm_post;
  const float* b_kv_norm; const float* b_w_kv; const float* b_norm_pre; const float* b_w_in; const float* b_w_o; const float* b_norm_post;
  float* out;
  bf16_t* wt_a_in; bf16_t* wt_a_uq; bf16_t* wt_a_ukv; bf16_t* wt_a_o; bf16_t* wt_b1; bf16_t* wt_b_o;
  bf16_t* xb;
  bf16_t* og;
  bf16_t* cq; bf16_t* ckv;
  bf16_t* gate;
  bf16_t* Q; bf16_t* Kb; bf16_t* Vt; bf16_t* kr;
  float* rs_x; float* ssq_cq; float* ssq_ckv; float* ssq_out; float2* rope; unsigned* bar; unsigned* counters;
};

typedef float f32x2 __attribute__((ext_vector_type(2)));
typedef __bf16 bf16x2n __attribute__((ext_vector_type(2)));
DI unsigned pk_bf16(float lo, float hi) { f32x2 v; v.x = lo; v.y = hi; return __builtin_bit_cast(unsigned, __builtin_convertvector(v, bf16x2n)); }
DI int get_tid() { int t = threadIdx.x; asm volatile("" : "+v"(t)); return t; }
DI float bf_lo(unsigned u) { return __uint_as_float(u << 16); }
DI float bf_hi(unsigned u) { return __uint_as_float(u & 0xffff0000u); }
DI float wave_sum(float v) {
#pragma unroll
  for (int o = 32; o > 0; o >>= 1) v += __shfl_xor(v, o);
  return v;
}
DI float silu_f(float v) { return v * __builtin_amdgcn_rcpf(1.0f + __builtin_amdgcn_exp2f(-v * LOG2E)); }
DI u32x2 pack4(f32x4 v) { u32x2 w; w.x = pk_bf16(v[0], v[1]); w.y = pk_bf16(v[2], v[3]); return w; }


#define XB_TMO      128
#define XB_XCNT(j)  (256  + 64 * (j))
#define XB_XSUB(j)  (1280 + 64 * (j))
#define XB_XGEN(j)  (2304 + 64 * (j))
#define XB_TOP      3328
#define XB_TOPGEN   3392
#define XCD_BAR_WORDS 3456
#define XB_SPIN_CAP (1u << 22)
#define LAS __attribute__((address_space(3)))
DI unsigned xb_ld(unsigned* p) { return __hip_atomic_load(p, __ATOMIC_RELAXED, __HIP_MEMORY_SCOPE_AGENT); }
DI unsigned xb_add(unsigned* p, unsigned v) { return __hip_atomic_fetch_add(p, v, __ATOMIC_RELAXED, __HIP_MEMORY_SCOPE_AGENT); }
DI unsigned xb_xcc_id() { return (unsigned)__builtin_amdgcn_s_getreg((3 << 11) | 20) & 0xFu; }
#define XB_SPIN(cond, bar) do { unsigned _sp = 0; while (cond) { __builtin_amdgcn_s_sleep(1); \
    if ((++_sp & 255u) == 0u) { if (xb_ld(&(bar)[XB_TMO])) break; if (_sp > XB_SPIN_CAP) { atomicAdd(&(bar)[XB_TMO], 1u); break; } } } } while (0)
struct XcdBarrier { unsigned* bar; unsigned x; volatile LAS unsigned* st; };
DI XcdBarrier xcd_barrier_post(unsigned* bar, volatile LAS unsigned* st) {
  XcdBarrier b; b.bar = bar; b.x = xb_xcc_id(); b.st = st;
  if (threadIdx.x == 0) (void)xb_add(&bar[XB_XCNT(b.x)], 1u);
  return b;
}
DI void xcd_barrier_complete(unsigned* bar, unsigned x, unsigned& nloc, unsigned& nx) {
  const unsigned G = gridDim.x * gridDim.y * gridDim.z;
  unsigned sum, cnt, mine, sp = 0u;
  for (;;) {
    sum = 0u; cnt = 0u; mine = 0u;
#pragma unroll
    for (unsigned j = 0; j < 16; ++j) { const unsigned c = xb_ld(&bar[XB_XCNT(j)]); sum += c; cnt += (c > 0u) ? 1u : 0u; mine = (j == x) ? c : mine; }
    if (sum == G) break;
    __builtin_amdgcn_s_sleep(1);
    if ((++sp & 255u) == 0u) { if (xb_ld(&bar[XB_TMO])) break; if (sp > XB_SPIN_CAP) { atomicAdd(&bar[XB_TMO], 1u); break; } }
  }
  nloc = mine > 0u ? mine : 1u; nx = cnt > 0u ? cnt : 1u;
}
DI void xcd_barrier(const XcdBarrier& b) {
  asm volatile("s_waitcnt vmcnt(0)" ::: "memory");
  __syncthreads();
  if (threadIdx.x == 0) {
    unsigned* bar = b.bar;
    __builtin_amdgcn_s_waitcnt(0);
    unsigned nloc = b.st[0], nx = b.st[1];
    if (nloc == 0u) { xcd_barrier_complete(bar, b.x, nloc, nx); b.st[0] = nloc; b.st[1] = nx; }
    const unsigned old = xb_add(&bar[XB_XSUB(b.x)], 1u);
    const unsigned gen = old / nloc;
    if (old + 1u == (gen + 1u) * nloc) {
      __builtin_amdgcn_fence(__ATOMIC_RELEASE, "agent");
      asm volatile("s_waitcnt vmcnt(0)" ::: "memory");
      const unsigned og = xb_add(&bar[XB_TOP], 1u);
      const unsigned tg = og / nx;
      if (og + 1u == (tg + 1u) * nx) xb_add(&bar[XB_TOPGEN], 1u);
      else XB_SPIN(xb_ld(&bar[XB_TOPGEN]) == tg, bar);
      __builtin_amdgcn_fence(__ATOMIC_ACQUIRE, "agent");
      xb_add(&bar[XB_XGEN(b.x)], 1u);
      asm volatile("s_waitcnt vmcnt(0)" ::: "memory");
    } else {
      XB_SPIN(xb_ld(&bar[XB_XGEN(b.x)]) == gen, bar);
      __builtin_amdgcn_fence(__ATOMIC_ACQUIRE, "agent");
      asm volatile("s_waitcnt vmcnt(0)" ::: "memory");
    }
  }
  __syncthreads();
}

struct ConvJob { const float* src; const float* gain; bf16_t* dst; int K, Nsrc, map, n0, k0; };
DI ConvJob conv_decode(const Params& p, int t) {
  ConvJob j; j.map = 0; int tt = t; int i;
  if (tt < 768) { i = tt / 384; tt %= 384; j.src = p.a_w_in + (size_t)i * 1024 * 1440; j.gain = p.a_norm_pre + i * 1024; j.dst = p.wt_a_in + (size_t)i * 1536 * 1024; j.K = 1024; j.Nsrc = 1440; j.map = 1; }
  else if ((tt -= 768) < 192) { i = tt / 96; tt %= 96; j.src = p.a_w_uq + (size_t)i * 256 * 1536; j.gain = p.a_q_norm + i * 256; j.dst = p.wt_a_uq + (size_t)i * 1536 * 256; j.K = 256; j.Nsrc = 1536; }
  else if ((tt -= 192) < 128) { i = tt / 64; tt %= 64; j.src = p.a_w_ukv + (size_t)i * 128 * 2048; j.gain = p.a_kv_norm + i * 128; j.dst = p.wt_a_ukv + (size_t)i * 2048 * 128; j.K = 128; j.Nsrc = 2048; j.map = 2; }
  else if ((tt -= 128) < 512) { i = tt / 256; tt %= 256; j.src = p.a_w_o + (size_t)i * 1024 * 1024; j.gain = nullptr; j.dst = p.wt_a_o + (size_t)i * 1024 * 1024; j.K = 1024; j.Nsrc = 1024; }
  else if ((tt -= 512) < 512) { j.src = p.b_w_kv; j.gain = p.b_kv_norm; j.dst = p.wt_b1; j.K = 1024; j.Nsrc = 2048; }
  else if ((tt -= 512) < 1024) { i = tt / 512; tt %= 512; j.src = p.b_w_in + (size_t)i * 1024 * 2048; j.gain = p.b_norm_pre + i * 1024; j.dst = p.wt_b1 + (size_t)(1 + i) * 2048 * 1024; j.K = 1024; j.Nsrc = 2048; }
  else { tt -= 1024; i = tt / 256; tt %= 256; j.src = p.b_w_o + (size_t)i * 1024 * 1024; j.gain = nullptr; j.dst = p.wt_b_o + (size_t)i * 1024 * 1024; j.K = 1024; j.Nsrc = 1024; }
  const int nkt = j.K >> 6; j.n0 = (tt / nkt) * 64; j.k0 = (tt % nkt) * 64;
  return j;
}
DI void conv_load(const ConvJob& j, int tid, f32x4 (&v)[4]) {
  const int n = j.n0 + (tid & 15) * 4; int sc = n;
  if (j.map == 1) sc = n < 384 ? n : (n < 1408 ? n + 32 : (n < 1440 ? n - 1408 + 384 : -1));
  if (j.map == 2) sc = ((n & 1023) >> 6) * 128 + (n >> 10) * 64 + (n & 63);
#pragma unroll
  for (int r = 0; r < 4; ++r) {
    const int kk = (tid >> 4) + 16 * r; v[r] = (f32x4){0.f, 0.f, 0.f, 0.f};
    if (sc >= 0) { v[r] = *(const f32x4*)(j.src + (size_t)(j.k0 + kk) * j.Nsrc + sc); if (j.gain) v[r] = v[r] * j.gain[j.k0 + kk]; }
  }
}
DI void conv_phase(const Params& p, char* lds) {
  const int tid512 = get_tid(), half = tid512 >> 8, tid = tid512 & 255;
  float (*tile)[65] = (float (*)[65])(lds + half * 16640);
  int t = blockIdx.x * 2 + half;
  if (t >= 3648) return;
  ConvJob J = conv_decode(p, t);
  f32x4 v[4];
  conv_load(J, tid, v);
  for (;;) {
    {
      const int nn = (tid & 15) * 4;
#pragma unroll
      for (int r = 0; r < 4; ++r) { const int kk = (tid >> 4) + 16 * r; tile[kk][nn] = v[r][0]; tile[kk][nn + 1] = v[r][1]; tile[kk][nn + 2] = v[r][2]; tile[kk][nn + 3] = v[r][3]; }
    }
    __syncthreads();
    const int tnx = t + gridDim.x * 2; const bool more = tnx < 3648;
    ConvJob Jn = J;
    if (more) { Jn = conv_decode(p, tnx); conv_load(Jn, tid, v); }
    {
      const int nn = tid >> 2, kc = (tid & 3) * 16;
      u32x4 w0, w1;
      w0.x = pk_bf16(tile[kc + 0][nn], tile[kc + 1][nn]); w0.y = pk_bf16(tile[kc + 2][nn], tile[kc + 3][nn]);
      w0.z = pk_bf16(tile[kc + 4][nn], tile[kc + 5][nn]); w0.w = pk_bf16(tile[kc + 6][nn], tile[kc + 7][nn]);
      w1.x = pk_bf16(tile[kc + 8][nn], tile[kc + 9][nn]); w1.y = pk_bf16(tile[kc + 10][nn], tile[kc + 11][nn]);
      w1.z = pk_bf16(tile[kc + 12][nn], tile[kc + 13][nn]); w1.w = pk_bf16(tile[kc + 14][nn], tile[kc + 15][nn]);
      bf16_t* d = J.dst + (size_t)(J.n0 + nn) * J.K + J.k0 + kc;
      *(u32x4*)d = w0; *(u32x4*)(d + 8) = w1;
    }
    __syncthreads();
    if (!more) break;
    J = Jn; t = tnx;
  }
}

DI void rope_phase(const Params& p) {
  for (int e = blockIdx.x * 512 + get_tid(); e < SEQL * 16; e += gridDim.x * 512) {
    const int pos = e >> 4, i = e & 15;
    const double bs = (i & 3) == 0 ? 1.0 : (i & 3) == 1 ? 0.56234132519034907 : (i & 3) == 2 ? 0.31622776601683794 : 0.17782794100389228;
    const double sc = (i >> 2) == 0 ? 1.0 : (i >> 2) == 1 ? 0.1 : (i >> 2) == 2 ? 0.01 : 0.001;
    const float inv = (float)(bs * sc);
    const float angf = (float)pos * inv;
    const double a = (double)angf;
    const double n = rint(a * 0.63661977236758134);
    double r = fma(-n, 1.5707963267948966, a); r = fma(-n, 6.123233995736766e-17, r);
    const double r2 = r * r;
    const double sp = r * (1.0 + r2 * (-1.0 / 6.0 + r2 * (1.0 / 120.0 + r2 * (-1.0 / 5040.0 + r2 * (1.0 / 362880.0 + r2 * (-1.0 / 39916800.0 + r2 * (1.0 / 6227020800.0)))))));
    const double cp = 1.0 + r2 * (-0.5 + r2 * (1.0 / 24.0 + r2 * (-1.0 / 720.0 + r2 * (1.0 / 40320.0 + r2 * (-1.0 / 3628800.0 + r2 * (1.0 / 479001600.0 + r2 * (-1.0 / 87178291200.0)))))));
    const int q = ((int)n) & 3;
    const double c = q == 0 ? cp : q == 1 ? -sp : q == 2 ? -cp : sp;
    const double s = q == 0 ? sp : q == 1 ? cp : q == 2 ? -sp : -cp;
    p.rope[e] = make_float2((float)c, (float)s);
  }
}

template <int MODE>
DI void e0_phase(const Params& p, const float* gpost) {
  const int tid = get_tid(); const int lane = tid & 63, w = tid >> 6;
  const int step = gridDim.x * 8;
  f32x4 g0[2], g1[2];
#pragma unroll
  for (int c = 0; c < 2; ++c) { g0[c] = (f32x4){0.f, 0.f, 0.f, 0.f}; g1[c] = g0[c]; if (MODE >= 1) { g0[c] = *(const f32x4*)(gpost + c * 512 + lane * 8); g1[c] = *(const f32x4*)(gpost + c * 512 + lane * 8 + 4); } }
  u32x4 xa[2][4], oa[2][2]; float sq[2];
#define E0_LOAD(S_, row_) do { const size_t off_ = (size_t)(row_) * 1024 + lane * 8; \
    if (MODE <= 1) { xa[S_][0] = *(const u32x4*)(p.x + off_); xa[S_][1] = *(const u32x4*)(p.x + off_ + 4); xa[S_][2] = *(const u32x4*)(p.x + off_ + 512); xa[S_][3] = *(const u32x4*)(p.x + off_ + 516); } \
    else { xa[S_][0] = *(const u32x4*)(p.xb + off_); xa[S_][1] = *(const u32x4*)(p.xb + off_ + 512); } \
    if (MODE >= 1) { oa[S_][0] = *(const u32x4*)(p.gate + off_); oa[S_][1] = *(const u32x4*)(p.gate + off_ + 512); sq[S_] = lane < 16 ? p.ssq_out[(size_t)(row_) * 16 + lane] : 0.f; } } while (0)
#define E0_PROC(S_, row_) do { float v[2][8]; \
    _Pragma("unroll") for (int c = 0; c < 2; ++c) { \
      if (MODE <= 1) { const u32x4 a_ = xa[S_][2 * c], b_ = xa[S_][2 * c + 1]; \
        v[c][0] = __uint_as_float(a_.x); v[c][1] = __uint_as_float(a_.y); v[c][2] = __uint_as_float(a_.z); v[c][3] = __uint_as_float(a_.w); \
        v[c][4] = __uint_as_float(b_.x); v[c][5] = __uint_as_float(b_.y); v[c][6] = __uint_as_float(b_.z); v[c][7] = __uint_as_float(b_.w); } \
      else { const u32x4 u_ = xa[S_][c]; v[c][0] = bf_lo(u_.x); v[c][1] = bf_hi(u_.x); v[c][2] = bf_lo(u_.y); v[c][3] = bf_hi(u_.y); v[c][4] = bf_lo(u_.z); v[c][5] = bf_hi(u_.z); v[c][6] = bf_lo(u_.w); v[c][7] = bf_hi(u_.w); } } \
    if (MODE >= 1) { const float rso = rsqrtf(wave_sum(sq[S_]) * (1.0f / 1024.0f) + EPSV); \
      _Pragma("unroll") for (int c = 0; c < 2; ++c) { const u32x4 ob = oa[S_][c]; \
        v[c][0] += bf_lo(ob.x) * rso * g0[c][0]; v[c][1] += bf_hi(ob.x) * rso * g0[c][1]; v[c][2] += bf_lo(ob.y) * rso * g0[c][2]; v[c][3] += bf_hi(ob.y) * rso * g0[c][3]; \
        v[c][4] += bf_lo(ob.z) * rso * g1[c][0]; v[c][5] += bf_hi(ob.z) * rso * g1[c][1]; v[c][6] += bf_lo(ob.w) * rso * g1[c][2]; v[c][7] += bf_hi(ob.w) * rso * g1[c][3]; } } \
    if (MODE == 3) { _Pragma("unroll") for (int c = 0; c < 2; ++c) { const size_t off_ = (size_t)(row_) * 1024 + c * 512 + lane * 8; \
        *(f32x4*)(p.out + off_) = (f32x4){v[c][0], v[c][1], v[c][2], v[c][3]}; *(f32x4*)(p.out + off_ + 4) = (f32x4){v[c][4], v[c][5], v[c][6], v[c][7]}; } } \
    else { float ss = 0.f; \
      _Pragma("unroll") for (int c = 0; c < 2; ++c) { u32x4 u_; \
        u_.x = pk_bf16(v[c][0], v[c][1]); u_.y = pk_bf16(v[c][2], v[c][3]); u_.z = pk_bf16(v[c][4], v[c][5]); u_.w = pk_bf16(v[c][6], v[c][7]); \
        _Pragma("unroll") for (int i = 0; i < 8; ++i) ss += v[c][i] * v[c][i]; \
        *(u32x4*)(p.xb + (size_t)(row_) * 1024 + c * 512 + lane * 8) = u_; } \
      ss = wave_sum(ss); if (lane == 0) p.rs_x[row_] = rsqrtf(ss * (1.0f / 1024.0f) + EPSV); } } while (0)
  int row = blockIdx.x * 8 + w;
  if (row < NTOK) E0_LOAD(0, row);
  for (; row < NTOK; row += 2 * step) {
    const int r1 = row + step, r2 = row + 2 * step;
    if (r1 < NTOK) E0_LOAD(1, r1);
    E0_PROC(0, row);
    if (r1 < NTOK) {
      if (r2 < NTOK) E0_LOAD(0, r2);
      E0_PROC(1, r1);
    }
  }
#undef E0_LOAD
#undef E0_PROC
}

#define MFMA16(a, b, c) __builtin_amdgcn_mfma_f32_16x16x32_bf16((a), (b), (c), 0, 0, 0)
#define MFMA32(a, b, c) __builtin_amdgcn_mfma_f32_32x32x16_bf16((a), (b), (c), 0, 0, 0)
#define GSTAGE 32768

template <bool TR>
DI void gemm_core(const bf16_t* __restrict__ A, const bf16_t* __restrict__ Bt, const int K, const int row0, const int col0,
                  char* lds, f32x4 (&acc)[8][4]) {
  const int tid = get_tid(), lane = tid & 63, wid = __builtin_amdgcn_readfirstlane(tid >> 6), wr = wid >> 2, wc = wid & 3, fr = lane & 15, fq = lane >> 4;
  const unsigned voff = (unsigned)(((lane >> 2) * K + (((lane & 3) ^ ((4 - ((lane >> 4) & 3)) & 3)) << 3)) * 2);
  const char* gsrc[4];
#pragma unroll
  for (int j = 0; j < 4; ++j) {
    const int q = wid * 4 + j;
    gsrc[j] = (q < 16 ? (const char*)(A + (size_t)(row0 + q * 16) * K) : (const char*)(Bt + (size_t)(col0 + (q - 16) * 16) * K)) + voff;
  }
  LAS char* ldsl = (LAS char*)lds;
  const unsigned ldsbase = (unsigned)(size_t)ldsl;
#define G_ISSUE(kt_, st_) do { _Pragma("unroll") for (int j_ = 0; j_ < 4; ++j_) \
    __builtin_amdgcn_global_load_lds((const unsigned*)(gsrc[j_] + (size_t)(kt_) * 64), (LAS unsigned*)(ldsl + (st_) * GSTAGE + (wid * 4 + j_) * 1024), 16, 0, 0); } while (0)
#pragma unroll
  for (int m = 0; m < 8; ++m)
#pragma unroll
    for (int n = 0; n < 4; ++n) acc[m][n] = (f32x4){0.f, 0.f, 0.f, 0.f};
  const int nk = K >> 5;
  G_ISSUE(0, 0);
  G_ISSUE(1, 1);
  G_ISSUE(2, 2);
  const int gx = ((4 - (fr >> 2)) & 3);
  const int aoff = (wr * 128 + fr) * 64 + ((fq ^ gx) << 4);
  const int boff = 16384 + (wc * 64 + fr) * 64 + ((fq ^ gx) << 4);
  for (int kt = 0; kt < nk; ++kt) {
    if (kt + 2 < nk) asm volatile("s_waitcnt vmcnt(8)" ::: "memory"); else if (kt + 1 < nk) asm volatile("s_waitcnt vmcnt(4)" ::: "memory"); else asm volatile("s_waitcnt vmcnt(0)" ::: "memory");
    __builtin_amdgcn_s_barrier();
    asm volatile("" ::: "memory");
    const unsigned sa = ldsbase + (kt & 3) * GSTAGE;
    bf16x8 af[8], bfr[4];
    asm volatile("ds_read_b128 %0, %9\n\tds_read_b128 %1, %9 offset:1024\n\tds_read_b128 %2, %9 offset:2048\n\tds_read_b128 %3, %9 offset:3072\n\t"
                 "ds_read_b128 %4, %8\n\tds_read_b128 %5, %8 offset:1024\n\tds_read_b128 %6, %8 offset:2048\n\tds_read_b128 %7, %8 offset:3072"
                 : "=&v"(bfr[0]), "=&v"(bfr[1]), "=&v"(bfr[2]), "=&v"(bfr[3]), "=&v"(af[0]), "=&v"(af[1]), "=&v"(af[2]), "=&v"(af[3])
                 : "v"(sa + aoff), "v"(sa + boff) : "memory");
    if (kt + 3 < nk) G_ISSUE(kt + 3, (kt + 3) & 3);
    asm volatile("s_waitcnt lgkmcnt(0)" : "+v"(bfr[0]), "+v"(bfr[1]), "+v"(bfr[2]), "+v"(bfr[3]), "+v"(af[0]), "+v"(af[1]), "+v"(af[2]), "+v"(af[3]) : : "memory");
#pragma unroll
    for (int m = 0; m < 4; ++m)
#pragma unroll
      for (int n = 0; n < 4; ++n) acc[m][n] = TR ? MFMA16(af[m], bfr[n], acc[m][n]) : MFMA16(bfr[n], af[m], acc[m][n]);
    asm volatile("ds_read_b128 %0, %4 offset:4096\n\tds_read_b128 %1, %4 offset:5120\n\tds_read_b128 %2, %4 offset:6144\n\tds_read_b128 %3, %4 offset:7168\n\t"
                 "s_waitcnt lgkmcnt(0)"
                 : "=&v"(af[4]), "=&v"(af[5]), "=&v"(af[6]), "=&v"(af[7]) : "v"(sa + aoff) : "memory");
#pragma unroll
    for (int m = 4; m < 8; ++m)
#pragma unroll
      for (int n = 0; n < 4; ++n) acc[m][n] = TR ? MFMA16(af[m], bfr[n], acc[m][n]) : MFMA16(bfr[n], af[m], acc[m][n]);
  }
  asm volatile("" ::: "memory");
  __builtin_amdgcn_s_barrier();
#undef G_ISSUE
}

DI void rope4(const float2* rope, int pos, int fq, f32x4& t1, f32x4& t2) {
  const f32x4 cs0 = *(const f32x4*)(rope + pos * 16 + 4 * fq);
  const f32x4 cs1 = *(const f32x4*)(rope + pos * 16 + 4 * fq + 2);
  const float c[4] = {cs0[0], cs0[2], cs1[0], cs1[2]}, s[4] = {cs0[1], cs0[3], cs1[1], cs1[3]};
#pragma unroll
  for (int r = 0; r < 4; ++r) { const float a = t1[r], b = t2[r]; t1[r] = a * c[r] - b * s[r]; t2[r] = a * s[r] + b * c[r]; }
}
DI f32x4 silu4(f32x4 v) { v[0] = silu_f(v[0]); v[1] = silu_f(v[1]); v[2] = silu_f(v[2]); v[3] = silu_f(v[3]); return v; }
DI float sumsq4(f32x4 v) { return v[0] * v[0] + v[1] * v[1] + v[2] * v[2] + v[3] * v[3]; }

template <bool TR> DI void epi_put(char* wreg, int m, int n, int fr, int fq, u32x2 v) {
  if (!TR) { const int row = 16 * m + fr, ch = 2 * n + (fq >> 1); *(u32x2*)(wreg + row * 128 + ((ch ^ (row & 7)) << 4) + (fq & 1) * 8) = v; }
  else { const int row = 16 * n + fr, ch = 2 * m + (fq >> 1); *(u32x2*)(wreg + row * 256 + ((ch ^ (row & 15)) << 4) + (fq & 1) * 8) = v; }
}
template <bool TR> DI void epi_flush(const char* wreg, int lane, bf16_t* dst, size_t ld) {
#pragma unroll
  for (int j = 0; j < 16; ++j) {
    if (!TR) { const int row = 8 * j + (lane >> 3), ch = lane & 7; const u32x4 v = *(const u32x4*)(wreg + row * 128 + ((ch ^ (row & 7)) << 4)); *(u32x4*)(dst + (size_t)row * ld + ch * 8) = v; }
    else { const int row = 4 * j + (lane >> 4), ch = lane & 15; const u32x4 v = *(const u32x4*)(wreg + row * 256 + ((ch ^ (row & 15)) << 4)); *(u32x4*)(dst + (size_t)row * ld + ch * 8) = v; }
  }
}
#define LDS_BARRIER() do { asm volatile("s_waitcnt lgkmcnt(0)" ::: "memory"); __builtin_amdgcn_s_barrier(); asm volatile("" ::: "memory"); } while (0)
#define EPI_END() do { asm volatile("" ::: "memory"); __builtin_amdgcn_s_barrier(); asm volatile("" ::: "memory"); } while (0)

template <int EPI>
DI void gemm_tile(const Params& p, const int layer, const int tm, int tn, char* lds) {
  const int tid = get_tid(), lane = tid & 63, wid = __builtin_amdgcn_readfirstlane(tid >> 6), wr = wid >> 2, wc = wid & 3, fr = lane & 15, fq = lane >> 4;
  const int row0 = tm * 256, rb = row0 + wr * 128;
  const int c0 = tn * 256 + wc * 64;
  char* wreg = lds + wid * 16384;
  f32x4 acc[8][4];
  if (EPI == 1) {
    float rs[8];
#pragma unroll
    for (int m = 0; m < 8; ++m) rs[m] = p.rs_x[rb + m * 16 + fr];
    gemm_core<false>(p.xb, p.wt_a_in + (size_t)layer * 1536 * 1024, 1024, row0, tn * 256, lds, acc);
    if (c0 < 384) {
      const bool isq = c0 < 256;
      float* sq = isq ? p.ssq_cq : p.ssq_ckv; const int sld = isq ? 4 : 2, si = isq ? (c0 >> 6) : ((c0 - 256) >> 6);
#pragma unroll
      for (int m = 0; m < 8; ++m) {
        float ss = 0.f;
#pragma unroll
        for (int n = 0; n < 4; ++n) { const f32x4 v = acc[m][n] * rs[m]; ss += sumsq4(v); epi_put<false>(wreg, m, n, fr, fq, pack4(v)); }
        ss += __shfl_xor(ss, 16); ss += __shfl_xor(ss, 32);
        if (fq == 0) sq[(size_t)(rb + m * 16 + fr) * sld + si] = ss;
      }
      if (isq) epi_flush<false>(wreg, lane, p.cq + (size_t)rb * 256 + c0, 256);
      else epi_flush<false>(wreg, lane, p.ckv + (size_t)rb * 128 + (c0 - 256), 128);
    } else if (c0 < 1408) {
#pragma unroll
      for (int m = 0; m < 8; ++m)
#pragma unroll
        for (int n = 0; n < 4; ++n) epi_put<false>(wreg, m, n, fr, fq, pack4(silu4(acc[m][n] * rs[m])));
      epi_flush<false>(wreg, lane, p.gate + (size_t)rb * 1024 + (c0 - 384), 1024);
    } else if (c0 == 1408) {
#pragma unroll
      for (int m = 0; m < 8; ++m) {
        const int row = rb + m * 16 + fr;
        f32x4 t1 = acc[m][0] * rs[m], t2 = acc[m][1] * rs[m];
        rope4(p.rope, row & (SEQL - 1), fq, t1, t2);
        *(u32x2*)(p.kr + (size_t)row * 32 + 4 * fq) = pack4(t1);
        *(u32x2*)(p.kr + (size_t)row * 32 + 16 + 4 * fq) = pack4(t2);
      }
    }
    EPI_END();
  } else if (EPI == 2) {
    float rs[8];
#pragma unroll
    for (int m = 0; m < 8; ++m) { const f32x4 sq = *(const f32x4*)(p.ssq_cq + (size_t)(rb + m * 16 + fr) * 4); rs[m] = rsqrtf((sq[0] + sq[1] + sq[2] + sq[3]) * (1.0f / 256.0f) + EPSV) * QSCALE_A; }
    gemm_core<false>(p.cq, p.wt_a_uq + (size_t)layer * 1536 * 256, 256, row0, tn * 256, lds, acc);
#pragma unroll
    for (int m = 0; m < 8; ++m) {
      const int row = rb + m * 16 + fr;
#pragma unroll
      for (int n = 0; n < 4; n += 2) {
        const int cg = c0 + n * 16;
        f32x4 t1 = acc[m][n] * rs[m], t2 = acc[m][n + 1] * rs[m];
        if ((cg % 96) == 64) rope4(p.rope, row & (SEQL - 1), fq, t1, t2);
        epi_put<false>(wreg, m, n, fr, fq, pack4(t1));
        epi_put<false>(wreg, m, n + 1, fr, fq, pack4(t2));
      }
    }
    epi_flush<false>(wreg, lane, p.Q + (size_t)rb * 1536 + c0, 1536);
    EPI_END();
  } else if (EPI == 3) {
    const bf16_t* Bt = p.wt_a_ukv + (size_t)layer * 2048 * 128;
    if (tn < 4) {
      float rs[8];
#pragma unroll
      for (int m = 0; m < 8; ++m) { const float2 sq = *(const float2*)(p.ssq_ckv + (size_t)(rb + m * 16 + fr) * 2); rs[m] = rsqrtf((sq.x + sq.y) * (1.0f / 128.0f) + EPSV); }
      gemm_core<false>(p.ckv, Bt, 128, row0, tn * 256, lds, acc);
#pragma unroll
      for (int m = 0; m < 8; ++m)
#pragma unroll
        for (int n = 0; n < 4; ++n) epi_put<false>(wreg, m, n, fr, fq, pack4(acc[m][n] * rs[m]));
      epi_flush<false>(wreg, lane, p.Kb + (size_t)rb * 1024 + c0, 1024);
    } else {
      gemm_core<true>(p.ckv, Bt, 128, row0, tn * 256, lds, acc);
      const int head = (c0 - 1024) >> 6, b = row0 >> 12;
#pragma unroll
      for (int m = 0; m < 8; ++m) {
        const int rowb = rb + m * 16 + 4 * fq;
        const f32x4 s0 = *(const f32x4*)(p.ssq_ckv + (size_t)rowb * 2), s1 = *(const f32x4*)(p.ssq_ckv + (size_t)rowb * 2 + 4);
        f32x4 rs;
        rs[0] = rsqrtf((s0[0] + s0[1]) * (1.0f / 128.0f) + EPSV); rs[1] = rsqrtf((s0[2] + s0[3]) * (1.0f / 128.0f) + EPSV);
        rs[2] = rsqrtf((s1[0] + s1[1]) * (1.0f / 128.0f) + EPSV); rs[3] = rsqrtf((s1[2] + s1[3]) * (1.0f / 128.0f) + EPSV);
#pragma unroll
        for (int n = 0; n < 4; ++n) epi_put<true>(wreg, m, n, fr, fq, pack4(acc[m][n] * rs));
      }
      epi_flush<true>(wreg, lane, p.Vt + ((size_t)(b * 16 + head) * 64) * SEQL + (rb & (SEQL - 1)), SEQL);
    }
    EPI_END();
  } else if (EPI == 4) {
    const int sec = layer == 0 ? (tn >> 2) : 2 + (tn >> 2);
    const bf16_t* Bt = layer == 0 ? p.wt_b1 : p.wt_b1 + (size_t)2 * 2048 * 1024;
    const int cw = (tn & 3) * 256 + wc * 64;
    if (sec != 1) {
      float rs[8];
#pragma unroll
      for (int m = 0; m < 8; ++m) rs[m] = p.rs_x[rb + m * 16 + fr] * (sec == 2 ? QSCALE_B : 1.0f);
      gemm_core<false>(p.xb, Bt, 1024, row0, tn * 256, lds, acc);
#pragma unroll
      for (int m = 0; m < 8; ++m)
#pragma unroll
        for (int n = 0; n < 4; ++n) { f32x4 v = acc[m][n] * rs[m]; if (sec == 3) v = silu4(v); epi_put<false>(wreg, m, n, fr, fq, pack4(v)); }
      epi_flush<false>(wreg, lane, (sec == 0 ? p.Kb : sec == 2 ? p.Q : p.gate) + (size_t)rb * 1024 + cw, 1024);
    } else {
      gemm_core<true>(p.xb, Bt, 1024, row0, tn * 256, lds, acc);
      const int b = row0 >> 12, h = cw >> 6;
#pragma unroll
      for (int m = 0; m < 8; ++m) {
        const f32x4 rs = *(const f32x4*)(p.rs_x + rb + m * 16 + 4 * fq);
#pragma unroll
        for (int n = 0; n < 4; ++n) epi_put<true>(wreg, m, n, fr, fq, pack4(acc[m][n] * rs));
      }
      epi_flush<true>(wreg, lane, p.Vt + ((size_t)(b * 16 + h) * 64) * SEQL + (rb & (SEQL - 1)), SEQL);
    }
    EPI_END();
  } else {
    const bf16_t* Bt = layer < 2 ? p.wt_a_o + (size_t)layer * 1024 * 1024 : p.wt_b_o + (size_t)(layer - 2) * 1024 * 1024;
    gemm_core<false>(p.og, Bt, 1024, row0, tn * 256, lds, acc);
#pragma unroll
    for (int m = 0; m < 8; ++m) {
      float ss = 0.f;
#pragma unroll
      for (int n = 0; n < 4; ++n) { const f32x4 v = acc[m][n]; ss += sumsq4(v); epi_put<false>(wreg, m, n, fr, fq, pack4(v)); }
      ss += __shfl_xor(ss, 16); ss += __shfl_xor(ss, 32);
      if (fq == 0) p.ssq_out[(size_t)(rb + m * 16 + fr) * 16 + (c0 >> 6)] = ss;
    }
    epi_flush<false>(wreg, lane, p.gate + (size_t)rb * 1024 + c0, 1024);
    EPI_END();
  }
}

template <int EPI>
DI void gemm_phase(const Params& p, const int layer, char* lds) {
  const int nN = EPI == 1 ? 6 : EPI == 23 ? 14 : EPI == 4 ? (layer == 0 ? 16 : 8) : 4;
  const int U = 128 * nN;
  for (int L = blockIdx.x; L < U; L += gridDim.x) {
    const int u = (L & 7) * (U >> 3) + (L >> 3);
    const int tm = u / nN, tn = u % nN;
    if (EPI == 23) { if (tn < 6) gemm_tile<2>(p, layer, tm, tn, lds); else gemm_tile<3>(p, layer, tm, tn - 6, lds); }
    else gemm_tile<(EPI == 23 ? 2 : EPI)>(p, layer, tm, tn, lds);
  }
}


DI void attn_store(const Params& p, char* wreg, const f32x16& o0, const f32x16& o1, float inv, size_t tokbase  , int h, int lane) {
  const int r = lane & 31, hh = lane >> 5;
  u32x4 gw[4];
#pragma unroll
  for (int j = 0; j < 4; ++j) gw[j] = *(const u32x4*)(p.gate + (tokbase + 8 * j + (lane >> 3)) * 1024 + h * 64 + (lane & 7) * 8);
#pragma unroll
  for (int dt = 0; dt < 2; ++dt) {
    const f32x16& ov = dt ? o1 : o0;
#pragma unroll
    for (int g = 0; g < 4; ++g) {
      const int c16 = dt * 8 + 2 * g + hh;
      *(f32x4*)(wreg + r * 256 + ((c16 ^ (r & 15)) << 4)) = (f32x4){ov[4 * g] * inv, ov[4 * g + 1] * inv, ov[4 * g + 2] * inv, ov[4 * g + 3] * inv};
    }
  }
#pragma unroll
  for (int j = 0; j < 4; ++j) {
    const int row = 8 * j + (lane >> 3), cp = lane & 7;
    const f32x4 a = *(const f32x4*)(wreg + row * 256 + (((2 * cp) ^ (row & 15)) << 4));
    const f32x4 b = *(const f32x4*)(wreg + row * 256 + (((2 * cp + 1) ^ (row & 15)) << 4));
    const size_t off = (tokbase + row) * 1024 + h * 64 + cp * 8;
    u32x4 w;
    w.x = pk_bf16(a[0] * bf_lo(gw[j].x), a[1] * bf_hi(gw[j].x)); w.y = pk_bf16(a[2] * bf_lo(gw[j].y), a[3] * bf_hi(gw[j].y));
    w.z = pk_bf16(b[0] * bf_lo(gw[j].z), b[1] * bf_hi(gw[j].z)); w.w = pk_bf16(b[2] * bf_lo(gw[j].w), b[3] * bf_hi(gw[j].w));
    *(u32x4*)(p.og + off) = w;
  }
}

DI void sb_phase(const Params& p, char* lds, unsigned* sflags) {
  const int tid = get_tid(), lane = tid & 63, w = tid >> 6, r = lane & 31, hh = lane >> 5;
  const int g = blockIdx.x & 7, nb = gridDim.x >> 3;
  const int klo = (tid >> 3) * 128 + (((tid & 7) ^ ((tid >> 4) & 7)) << 4);
  const int vlo = 8192 + (tid >> 3) * 128 + ((((tid & 6)) ^ ((tid >> 4) & 7)) << 4) + (tid & 1) * 8;
  const int ksw0 = (r >> 1) & 7, vsw = (r >> 1) & 7;
#define SB_LOAD(X_, KR_, VR_) do { KR_ = *(const u32x4*)(kp + (size_t)((X_) * 64) * 1024); VR_ = *(const u32x4*)(vp + (X_) * 64); } while (0)
#define SB_WRITE(X_, KR_, VR_) do { char* base_ = lds + ((X_) & 7) * 16384; *(u32x4*)(base_ + klo) = KR_; \
    u32x2 lo_, hi_; lo_.x = VR_.x; lo_.y = VR_.y; hi_.x = VR_.z; hi_.y = VR_.w; *(u32x2*)(base_ + vlo) = lo_; *(u32x2*)(base_ + (vlo ^ 16)) = hi_; } while (0)
#define SB_COORDS(l_) const int bh_ = g + 8 * ((l_) >> 4), b = bh_ >> 4, h = bh_ & 15, qb = 15 - (((l_) + ((l_) >> 5)) & 15); \
    const size_t tok0 = (size_t)b * SEQL; const int q0 = qb * 256, qrow = q0 + 32 * w + r, T0 = 4 * qb; \
    const bf16_t* kp = p.Kb + (tok0 + (tid >> 3)) * 1024 + h * 64 + (tid & 7) * 8; \
    const bf16_t* vp = p.Vt + ((size_t)(b * 16 + h) * 64 + (tid >> 3)) * SEQL + (tid & 7) * 8;
#define SB_PREFETCH_UNIT() do { const bf16_t* Qp = p.Q + (tok0 + qrow) * 1024 + h * 64 + 8 * hh; \
    _Pragma("unroll") for (int s_ = 0; s_ < 4; ++s_) qf[s_] = *(const bf16x8*)(Qp + 16 * s_); \
    _Pragma("unroll") for (int i_ = 0; i_ < 4; ++i_) SB_LOAD(T0 + i_, k4[i_], v4[i_]); } while (0)
  bf16x8 qf[4]; u32x4 k4[4], v4[4];
  int l = blockIdx.x >> 3;
  if (l >= 256) return;
  { SB_COORDS(l); SB_PREFETCH_UNIT(); }
  for (; l < 256; l += nb) {
    SB_COORDS(l);
#pragma unroll
    for (int i = 0; i < 4; ++i) SB_WRITE(T0 + i, k4[i], v4[i]);
#pragma unroll
    for (int i = 0; i < 4; ++i) if (T0 - 4 + i >= 0) SB_LOAD(T0 - 4 + i, k4[i], v4[i]);
    __syncthreads();
    u32x4 kreg, vreg;
    f32x16 o0, o1;
#pragma unroll
    for (int i = 0; i < 16; ++i) { o0[i] = 0.f; o1[i] = 0.f; }
    float carry = 1.0f;
    bool done_w = false;
    for (int s = 0;; ++s) {
      const int L = T0 - s - 1;
      if (s >= 4 && L >= 0) SB_LOAD(L, kreg, vreg);
      const int X = T0 + (w >> 1) - s;
      if (X < 0) done_w = true;
      if (!done_w) {
        const int k0 = X * 64;
        const char* kb = lds + (X & 7) * 16384; const char* vb = kb + 8192;
        const bool live1 = k0 + 32 < q0 + 32 * w + 31;
        f32x16 s0, s1;
#pragma unroll
        for (int i = 0; i < 16; ++i) { s0[i] = 0.f; s1[i] = 0.f; }
#pragma unroll
        for (int ks = 0; ks < 4; ++ks) {
          const int co = ((2 * ks + hh) ^ ksw0) << 4;
          const bf16x8 k0f = *(const bf16x8*)(kb + r * 128 + co);
          s0 = MFMA32(k0f, qf[ks], s0);
          if (live1) { const bf16x8 k1f = *(const bf16x8*)(kb + (32 + r) * 128 + co); s1 = MFMA32(k1f, qf[ks], s1); }
        }
        const int kbase = k0 + 4 * hh;
        const bool need_mask = k0 + 63 >= q0 + 32 * w;
        bool act[2] = {false, false};
#pragma unroll
        for (int kt = 1; kt >= 0; --kt) {
          if ((kt == 1 && !live1) || done_w) continue;
          act[kt] = true;
          f32x16& sv = kt ? s1 : s0;
          float om[16];
#pragma unroll
          for (int i = 0; i < 16; ++i) {
            const float z = sv[i];
            const float e = __builtin_amdgcn_exp2f(-fmaxf(z, -126.0f));
            float be = __builtin_amdgcn_rcpf(1.0f + e);
            float o_ = e * be;
            if (need_mask) { const int key = kbase + 32 * kt + (i & 3) + 8 * (i >> 2); if (key >= qrow) { be = 0.f; o_ = 1.f; } }
            sv[i] = be; om[i] = o_;
          }
          float G[4], Go[4];
#pragma unroll
          for (int m = 0; m < 4; ++m) { G[m] = (om[4 * m] * om[4 * m + 1]) * (om[4 * m + 2] * om[4 * m + 3]); Go[m] = __shfl_xor(G[m], 32); }
          float run = carry;
#pragma unroll
          for (int m = 3; m >= 0; --m) {
            float a = hh == 0 ? run * Go[m] : run;
            sv[4 * m + 3] *= a; a *= om[4 * m + 3];
            sv[4 * m + 2] *= a; a *= om[4 * m + 2];
            sv[4 * m + 1] *= a; a *= om[4 * m + 1];
            sv[4 * m + 0] *= a;
            run *= G[m] * Go[m];
          }
          carry = run;
          done_w = __all(carry < SB_DONE_THR);
        }
        if (act[0]) {
          bf16x8 pf0, pf1; u32x4 t;
          t.x = pk_bf16(s0[0], s0[1]); t.y = pk_bf16(s0[2], s0[3]); t.z = pk_bf16(s0[4], s0[5]); t.w = pk_bf16(s0[6], s0[7]); pf0 = __builtin_bit_cast(bf16x8, t);
          t.x = pk_bf16(s0[8], s0[9]); t.y = pk_bf16(s0[10], s0[11]); t.z = pk_bf16(s0[12], s0[13]); t.w = pk_bf16(s0[14], s0[15]); pf1 = __builtin_bit_cast(bf16x8, t);
          const int c0 = ((0 + hh) ^ vsw) << 4, c1 = ((2 + hh) ^ vsw) << 4;
          o0 = MFMA32(*(const bf16x8*)(vb + r * 128 + c0), pf0, o0); o1 = MFMA32(*(const bf16x8*)(vb + (32 + r) * 128 + c0), pf0, o1);
          o0 = MFMA32(*(const bf16x8*)(vb + r * 128 + c1), pf1, o0); o1 = MFMA32(*(const bf16x8*)(vb + (32 + r) * 128 + c1), pf1, o1);
        }
        if (act[1]) {
          bf16x8 pf2, pf3; u32x4 t;
          t.x = pk_bf16(s1[0], s1[1]); t.y = pk_bf16(s1[2], s1[3]); t.z = pk_bf16(s1[4], s1[5]); t.w = pk_bf16(s1[6], s1[7]); pf2 = __builtin_bit_cast(bf16x8, t);
          t.x = pk_bf16(s1[8], s1[9]); t.y = pk_bf16(s1[10], s1[11]); t.z = pk_bf16(s1[12], s1[13]); t.w = pk_bf16(s1[14], s1[15]); pf3 = __builtin_bit_cast(bf16x8, t);
          const int c2 = ((4 + hh) ^ vsw) << 4, c3 = ((6 + hh) ^ vsw) << 4;
          o0 = MFMA32(*(const bf16x8*)(vb + r * 128 + c2), pf2, o0); o1 = MFMA32(*(const bf16x8*)(vb + (32 + r) * 128 + c2), pf2, o1);
          o0 = MFMA32(*(const bf16x8*)(vb + r * 128 + c3), pf3, o0); o1 = MFMA32(*(const bf16x8*)(vb + (32 + r) * 128 + c3), pf3, o1);
        }
      }
      if (lane == 0) sflags[(s & 1) * 8 + w] = done_w ? 1u : 0u;
      if (s == 0) {
#pragma unroll
        for (int i = 0; i < 4; ++i) if (T0 - 4 + i >= 0) SB_WRITE(T0 - 4 + i, k4[i], v4[i]);
      } else if (s >= 4 && L >= 0) SB_WRITE(L, kreg, vreg);
      __syncthreads();
      { const unsigned* f = sflags + (s & 1) * 8; if (f[0] & f[1] & f[2] & f[3] & f[4] & f[5] & f[6] & f[7]) break; }
    }
    if (l + nb < 256) {
      const int ln = l + nb;
      const int bhn = g + 8 * (ln >> 4), bn = bhn >> 4, hn = bhn & 15, qbn = 15 - ((ln + (ln >> 5)) & 15);
      const size_t tokn = (size_t)bn * SEQL; const int qrown = qbn * 256 + 32 * w + r, T0n = 4 * qbn;
      const bf16_t* Qp = p.Q + (tokn + qrown) * 1024 + hn * 64 + 8 * hh;
#pragma unroll
      for (int s_ = 0; s_ < 4; ++s_) qf[s_] = *(const bf16x8*)(Qp + 16 * s_);
      const bf16_t* kpn = p.Kb + (tokn + (tid >> 3)) * 1024 + hn * 64 + (tid & 7) * 8;
      const bf16_t* vpn = p.Vt + ((size_t)(bn * 16 + hn) * 64 + (tid >> 3)) * SEQL + (tid & 7) * 8;
#pragma unroll
      for (int i = 0; i < 4; ++i) { k4[i] = *(const u32x4*)(kpn + (size_t)((T0n + i) * 64) * 1024); v4[i] = *(const u32x4*)(vpn + (T0n + i) * 64); }
    }
    attn_store(p, lds + w * 8192, o0, o1, 1.0f, tok0 + q0 + 32 * w, h, lane);
    LDS_BARRIER();
  }
#undef SB_LOAD
#undef SB_WRITE
#undef SB_COORDS
#undef SB_PREFETCH_UNIT
}

DI void mla_qk(const char* kb, const bf16x8 (&qf)[6], const bf16x8 onek, const bf16x8 bias, int r, int hh, int ksw, f32x16& s0, f32x16& s1) {
  const unsigned a0 = (unsigned)(size_t)(LAS const char*)kb + r * 256, a1 = a0 + 32 * 256;
  unsigned co[6];
#pragma unroll
  for (int ks = 0; ks < 6; ++ks) co[ks] = ((2 * ks + hh) ^ ksw) << 4;
#pragma unroll
  for (int i = 0; i < 16; ++i) { s0[i] = 0.f; s1[i] = 0.f; }
  bf16x8 kf[6];
  asm volatile("ds_read_b128 %0, %6\n\tds_read_b128 %1, %7\n\tds_read_b128 %2, %8\n\tds_read_b128 %3, %9\n\tds_read_b128 %4, %10\n\tds_read_b128 %5, %11"
               : "=&v"(kf[0]), "=&v"(kf[1]), "=&v"(kf[2]), "=&v"(kf[3]), "=&v"(kf[4]), "=&v"(kf[5])
               : "v"(a0 + co[0]), "v"(a1 + co[0]), "v"(a0 + co[1]), "v"(a1 + co[1]), "v"(a0 + co[2]), "v"(a1 + co[2]) : "memory");
  s0 = MFMA32(onek, bias, s0);
  s1 = MFMA32(onek, bias, s1);
  asm volatile("s_waitcnt lgkmcnt(0)" : "+v"(kf[0]), "+v"(kf[1]), "+v"(kf[2]), "+v"(kf[3]), "+v"(kf[4]), "+v"(kf[5]) : : "memory");
#pragma unroll
  for (int k3 = 0; k3 < 3; ++k3) { s0 = MFMA32(kf[2 * k3], qf[k3], s0); s1 = MFMA32(kf[2 * k3 + 1], qf[k3], s1); }
  bf16x8 kg[6];
  asm volatile("ds_read_b128 %0, %6\n\tds_read_b128 %1, %7\n\tds_read_b128 %2, %8\n\tds_read_b128 %3, %9\n\tds_read_b128 %4, %10\n\tds_read_b128 %5, %11\n\t"
               "s_waitcnt lgkmcnt(0)"
               : "=&v"(kg[0]), "=&v"(kg[1]), "=&v"(kg[2]), "=&v"(kg[3]), "=&v"(kg[4]), "=&v"(kg[5])
               : "v"(a0 + co[3]), "v"(a1 + co[3]), "v"(a0 + co[4]), "v"(a1 + co[4]), "v"(a0 + co[5]), "v"(a1 + co[5]) : "memory");
#pragma unroll
  for (int k3 = 0; k3 < 3; ++k3) { s0 = MFMA32(kg[2 * k3], qf[3 + k3], s0); s1 = MFMA32(kg[2 * k3 + 1], qf[3 + k3], s1); }
}
DI void mla_mask(f32x16& s0, f32x16& s1, int kbase, int qrow) {
#pragma unroll
  for (int i = 0; i < 16; ++i) {
    const int key = kbase + (i & 3) + 8 * (i >> 2);
    if (key > qrow) s0[i] = -INFINITY;
    if (key + 32 > qrow) s1[i] = -INFINITY;
  }
}
DI bf16x8 mla_bias_frag(float m_run, int hh) {
  u32x4 t; t.x = hh == 0 ? (__float_as_uint(-m_run) >> 16) : 0u; t.y = 0u; t.z = 0u; t.w = 0u;
  return __builtin_bit_cast(bf16x8, t);
}
DI float mla_softmax_pv(f32x16& s0, f32x16& s1, f32x16& o0, f32x16& o1, f32x16& lacc, float& m_run, bf16x8& bias, const bf16x8 ones,
                        const char* vb, int r, int hh, int vsw, bool first) {
  float mx = fmaxf(fmaxf(s0[0], s0[1]), s0[2]);
#pragma unroll
  for (int i = 3; i < 15; i += 2) mx = fmaxf(fmaxf(mx, s0[i]), s0[i + 1]);
  mx = fmaxf(mx, s0[15]);
#pragma unroll
  for (int i = 0; i < 16; i += 2) mx = fmaxf(fmaxf(mx, s1[i]), s1[i + 1]);
  float delta = 0.f;
  if (__any(first || mx > 8.0f)) {
    mx = fmaxf(mx, __shfl_xor(mx, 32));
    const bool upd = (first && mx > -1e30f) || mx > 8.0f;
    if (upd) { const float m_new = __uint_as_float(pk_bf16(m_run + mx, 0.f) << 16); delta = m_new - m_run; m_run = m_new; }
    const float alpha = __builtin_amdgcn_exp2f(-delta);
    s0 = s0 - delta; s1 = s1 - delta;
    o0 = o0 * alpha; o1 = o1 * alpha; lacc = lacc * alpha;
    bias = mla_bias_frag(m_run, hh);
  }
#pragma unroll
  for (int i = 0; i < 16; ++i) { s0[i] = __builtin_amdgcn_exp2f(s0[i]); s1[i] = __builtin_amdgcn_exp2f(s1[i]); }
#pragma unroll
  for (int i = 0; i < 16; ++i) lacc[i] += s0[i] + s1[i];
  bf16x8 pf[4];
  {
    u32x4 t4;
    t4.x = pk_bf16(s0[0], s0[1]); t4.y = pk_bf16(s0[2], s0[3]); t4.z = pk_bf16(s0[4], s0[5]); t4.w = pk_bf16(s0[6], s0[7]); pf[0] = __builtin_bit_cast(bf16x8, t4);
    t4.x = pk_bf16(s0[8], s0[9]); t4.y = pk_bf16(s0[10], s0[11]); t4.z = pk_bf16(s0[12], s0[13]); t4.w = pk_bf16(s0[14], s0[15]); pf[1] = __builtin_bit_cast(bf16x8, t4);
    t4.x = pk_bf16(s1[0], s1[1]); t4.y = pk_bf16(s1[2], s1[3]); t4.z = pk_bf16(s1[4], s1[5]); t4.w = pk_bf16(s1[6], s1[7]); pf[2] = __builtin_bit_cast(bf16x8, t4);
    t4.x = pk_bf16(s1[8], s1[9]); t4.y = pk_bf16(s1[10], s1[11]); t4.z = pk_bf16(s1[12], s1[13]); t4.w = pk_bf16(s1[14], s1[15]); pf[3] = __builtin_bit_cast(bf16x8, t4);
  }
#pragma unroll
  for (int s4 = 0; s4 < 4; ++s4) {
    const int c0 = ((2 * s4 + hh) ^ vsw) << 4;
    o0 = MFMA32(*(const bf16x8*)(vb + r * 128 + c0), pf[s4], o0);
    o1 = MFMA32(*(const bf16x8*)(vb + (32 + r) * 128 + c0), pf[s4], o1);
  }
  return delta;
}

DI void mla_unit(const Params& p, const int b, const int h, const int qb, char* lds) {
  const int tid = get_tid(), lane = tid & 63, w = tid >> 6, r = lane & 31, hh = lane >> 5;
  const int q0 = qb * 256, qrow = q0 + 32 * w + r;
  const size_t tok0 = (size_t)b * SEQL;
  bf16x8 qf[6];
  {
    const bf16_t* Qp = p.Q + (tok0 + qrow) * 1536 + h * 96 + 8 * hh;
#pragma unroll
    for (int s = 0; s < 6; ++s) qf[s] = *(const bf16x8*)(Qp + 16 * s);
  }
  const bf16_t* Vg = p.Vt + ((size_t)(b * 16 + h) * 64) * SEQL;
  const bf16_t* kpn = p.Kb + (tok0 + (tid >> 3)) * 1024 + h * 64 + (tid & 7) * 8;
  const bf16_t* kpr = p.kr + (tok0 + ((tid & 255) >> 2)) * 32 + (tid & 3) * 8;
  const bf16_t* vp = Vg + (size_t)(tid >> 3) * SEQL + (tid & 7) * 8;
  const int klo_n = (tid >> 3) * 256 + (((tid & 7) ^ ((tid >> 3) & 15)) << 4);
  const int klo_r = ((tid & 255) >> 2) * 256 + (((8 + (tid & 3)) ^ (((tid & 255) >> 2) & 15)) << 4);
  const int vlo0 = 32768 + (tid >> 3) * 128 + ((((tid & 6)) ^ ((tid >> 4) & 7)) << 4) + (tid & 1) * 8;
  const bool has_r = tid < 256;
  u32x4 kreg[2], vreg[1];
#define M_KLOAD(t_) do { kreg[0] = *(const u32x4*)(kpn + (size_t)((t_) * 64) * 1024); if (has_r) kreg[1] = *(const u32x4*)(kpr + (size_t)((t_) * 64) * 32); } while (0)
#define M_VLOAD(t_) do { vreg[0] = *(const u32x4*)(vp + (t_) * 64); } while (0)
#define M_KWRITE(buf_) do { *(u32x4*)(lds + (buf_) * 16384 + klo_n) = kreg[0]; if (has_r) *(u32x4*)(lds + (buf_) * 16384 + klo_r) = kreg[1]; } while (0)
#define M_VWRITE(buf_) do { u32x2 lo_, hi_; lo_.x = vreg[0].x; lo_.y = vreg[0].y; hi_.x = vreg[0].z; hi_.y = vreg[0].w; \
      *(u32x2*)(lds + (buf_) * 8192 + vlo0) = lo_; *(u32x2*)(lds + (buf_) * 8192 + (vlo0 ^ 16)) = hi_; } while (0)
  const int n = 4 * qb + 4;
  const int nw = 4 * qb + 1 + (w >> 1);
  const int ksw = r & 15, vsw = (r >> 1) & 7;
  f32x16 o0, o1;
#pragma unroll
  for (int i = 0; i < 16; ++i) { o0[i] = 0.f; o1[i] = 0.f; }
  f32x16 lacc;
#pragma unroll
  for (int i = 0; i < 16; ++i) lacc[i] = 0.f;
  float m_run = 0.f;
  bf16x8 bias = mla_bias_frag(0.f, hh), onek, ones;
  { u32x4 t; t.x = hh == 0 ? 0x3F80u : 0u; t.y = 0u; t.z = 0u; t.w = 0u; onek = __builtin_bit_cast(bf16x8, t); t.x = 0x3F803F80u; t.y = t.x; t.z = t.x; t.w = t.x; ones = __builtin_bit_cast(bf16x8, t); }
  {
    u32x4 k1n, k1r;
    M_KLOAD(0); M_VLOAD(0);
    k1n = *(const u32x4*)(kpn + (size_t)64 * 1024); if (has_r) k1r = *(const u32x4*)(kpr + (size_t)64 * 32);
    M_KWRITE(0); M_VWRITE(0);
    *(u32x4*)(lds + 16384 + klo_n) = k1n; if (has_r) *(u32x4*)(lds + 16384 + klo_r) = k1r;
  }
  __syncthreads();
  if (w >= 4) __builtin_amdgcn_s_setprio(1);
  if (n > 2) M_KLOAD(2);
  M_VLOAD(1);
  f32x16 sc0, sc1;
  mla_qk(lds, qf, onek, bias, r, hh, ksw, sc0, sc1);
  if (63 > q0 + 32 * w) mla_mask(sc0, sc1, 4 * hh, qrow);
  for (int idx = 0; idx < n; ++idx) {
    const char* vb = lds + 32768 + (idx & 1) * 8192;
    if (idx + 1 < nw) {
      f32x16 sn0, sn1;
      mla_qk(lds + ((idx + 1) & 1) * 16384, qf, onek, bias, r, hh, ksw, sn0, sn1);
      const float dl = mla_softmax_pv(sc0, sc1, o0, o1, lacc, m_run, bias, ones, vb, r, hh, vsw, idx == 0);
      if (__any(dl != 0.f)) { sn0 = sn0 - dl; sn1 = sn1 - dl; }
      if ((idx + 1) * 64 + 63 > q0 + 32 * w) mla_mask(sn0, sn1, (idx + 1) * 64 + 4 * hh, qrow);
      sc0 = sn0; sc1 = sn1;
    } else if (idx < nw) {
      (void)mla_softmax_pv(sc0, sc1, o0, o1, lacc, m_run, bias, ones, vb, r, hh, vsw, idx == 0);
    }
    if (idx + 2 < n) M_KWRITE(idx & 1);
    if (idx + 1 < n) M_VWRITE((idx + 1) & 1);
    if (idx + 3 < n) M_KLOAD(idx + 3);
    if (idx + 2 < n) M_VLOAD(idx + 2);
    LDS_BARRIER();
  }
#undef M_KLOAD
#undef M_VLOAD
#undef M_KWRITE
#undef M_VWRITE
  __builtin_amdgcn_s_setprio(0);
  float lsum = 0.f;
#pragma unroll
  for (int i = 0; i < 16; ++i) lsum += lacc[i];
  const float inv = 1.0f / (lsum + __shfl_xor(lsum, 32));
  attn_store(p, lds + w * 8192, o0, o1, inv, tok0 + q0 + 32 * w, h, lane);
}

template <bool SB>
DI void attn_phase(const Params& p, const int slot, char* lds, unsigned* sflags, int* s_unit) {
  const int grp0 = blockIdx.x & 7;
  for (int j = 0; j < 8; ++j) {
    const int g = (grp0 + j) & 7;
    if (threadIdx.x == 0) *s_unit = (int)atomicAdd(p.counters + slot * 8 + g, 1u);
    __syncthreads();
    int l = *s_unit;
    __syncthreads();
    while (l < 256) {
      int nxt = 0;
      if (threadIdx.x == 0) nxt = (int)atomicAdd(p.counters + slot * 8 + g, 1u);
      const int bh = g + 8 * (l & 15), qb = 15 - (l >> 4);
      mla_unit(p, bh >> 4, bh & 15, qb, lds);
      if (threadIdx.x == 0) *s_unit = nxt;
      __syncthreads();
      l = *s_unit;
      __syncthreads();
    }
  }
}

__global__ void __launch_bounds__(512, 2) mk_fwd(Params p, int ph_lo, int ph_hi) {
  __shared__ __attribute__((aligned(16))) char lds[4 * GSTAGE];
  __shared__ unsigned sflags[16];
  __shared__ int s_unit;
  __shared__ uint4 xb_words;
  if (threadIdx.x == 0) xb_words = make_uint4(0u, 0u, 0u, 0u);
  __syncthreads();
  (void)xcd_barrier_post(p.bar, (volatile LAS unsigned*)&xb_words);
#ifndef PROBE_REP
#define PROBE_REP 0
#endif
#define GRID_BARRIER() do { if (ph_hi > 1000) cg::this_grid().sync();   \
    else { XcdBarrier xb; xb.bar = p.bar; xb.x = xb_xcc_id(); xb.st = (volatile LAS unsigned*)&xb_words; xcd_barrier(xb); } } while (0)
#define RUN_PHASE(type_, last_, ...) do { const int nrep_ = ((PROBE_REP >> (type_)) & 1) ? 2 : 1; \
    for (int rep = 0; rep < nrep_; ++rep) { __VA_ARGS__; if (rep + 1 < nrep_) GRID_BARRIER(); } if (!(last_)) GRID_BARRIER(); } while (0)
  RUN_PHASE(0, false, conv_phase(p, lds); rope_phase(p); e0_phase<0>(p, nullptr));
  for (int layer = 0; layer < 2; ++layer) {
    RUN_PHASE(1, false, gemm_phase<1>(p, layer, lds));
    RUN_PHASE(2, false, gemm_phase<23>(p, layer, lds));
    RUN_PHASE(3, false, attn_phase<false>(p, layer + 4 * rep, lds, sflags, &s_unit));
    RUN_PHASE(4, false, gemm_phase<5>(p, layer, lds));
    if (layer == 0) RUN_PHASE(5, false, e0_phase<1>(p, p.a_norm_post));
    else RUN_PHASE(5, false, e0_phase<2>(p, p.a_norm_post + 1024));
  }
  for (int layer = 0; layer < 2; ++layer) {
    RUN_PHASE(6, false, gemm_phase<4>(p, layer, lds));
    RUN_PHASE(7, false, sb_phase(p, lds, sflags));
    RUN_PHASE(4, false, gemm_phase<5>(p, 2 + layer, lds));
    if (layer == 0) RUN_PHASE(5, false, e0_phase<2>(p, p.b_norm_post));
    else RUN_PHASE(5, true, e0_phase<3>(p, p.b_norm_post + 1024));
  }
}

extern "C" void kernel_launch(void* const* d_in, const int* in_sizes, int n_in, void* d_out, int out_size, void* d_ws, size_t ws_size, hipStream_t stream) {
  (void)in_sizes; (void)n_in; (void)out_size;
  Params p{};
  p.x = (const float*)d_in[0]; p.a_norm_pre = (const float*)d_in[1]; p.a_w_in = (const float*)d_in[2]; p.a_q_norm = (const float*)d_in[3];
  p.a_w_uq = (const float*)d_in[4]; p.a_kv_norm = (const float*)d_in[5]; p.a_w_ukv = (const float*)d_in[6]; p.a_w_o = (const float*)d_in[7];
  p.a_norm_post = (const float*)d_in[8]; p.b_kv_norm = (const float*)d_in[9]; p.b_w_kv = (const float*)d_in[10]; p.b_norm_pre = (const float*)d_in[11];
  p.b_w_in = (const float*)d_in[12]; p.b_w_o = (const float*)d_in[13]; p.b_norm_post = (const float*)d_in[14];
  p.out = (float*)d_out;
  char* w = (char*)d_ws; size_t off = 0;
  auto take = [&](size_t bytes) { char* r = w + off; off += (bytes + 255) & ~(size_t)255; return r; };
  p.wt_a_in = (bf16_t*)take((size_t)2 * 1536 * 1024 * 2);
  p.wt_a_uq = (bf16_t*)take((size_t)2 * 1536 * 256 * 2);
  p.wt_a_ukv = (bf16_t*)take((size_t)2 * 2048 * 128 * 2);
  p.wt_a_o = (bf16_t*)take((size_t)2 * 1024 * 1024 * 2);
  p.wt_b1 = (bf16_t*)take((size_t)3 * 2048 * 1024 * 2);
  p.wt_b_o = (bf16_t*)take((size_t)2 * 1024 * 1024 * 2);
  p.xb = (bf16_t*)take((size_t)NTOK * 1024 * 2);
  p.cq = (bf16_t*)take((size_t)NTOK * 256 * 2);
  p.ckv = (bf16_t*)take((size_t)NTOK * 128 * 2);
  p.gate = (bf16_t*)take((size_t)NTOK * 1024 * 2);
  p.Q = (bf16_t*)take((size_t)NTOK * 1536 * 2);
  p.Kb = (bf16_t*)take((size_t)NTOK * 1024 * 2);
  p.og = (bf16_t*)take((size_t)NTOK * 1024 * 2);
  p.Vt = (bf16_t*)take((size_t)NTOK * 1024 * 2);
  p.kr = (bf16_t*)take((size_t)NTOK * 32 * 2);
  p.rs_x = (float*)take((size_t)NTOK * 4);
  p.ssq_cq = (float*)take((size_t)NTOK * 4 * 4);
  p.ssq_ckv = (float*)take((size_t)NTOK * 2 * 4);
  p.ssq_out = (float*)take((size_t)NTOK * 16 * 4);
  p.rope = (float2*)take((size_t)SEQL * 16 * 8);
  p.bar = (unsigned*)take((size_t)XCD_BAR_WORDS * 4 + 256);
  p.counters = p.bar + XCD_BAR_WORDS;
  if (off > ws_size) { fprintf(stderr, "workspace too small: need %zu have %zu\n", off, ws_size); return; }
  static int grid_blocks = 0;
  if (!grid_blocks) {
    int dev = 0, cus = 0, per_cu = 0;
    hipGetDevice(&dev);
    hipDeviceGetAttribute(&cus, hipDeviceAttributeMultiprocessorCount, dev);
    hipOccupancyMaxActiveBlocksPerMultiprocessor(&per_cu, mk_fwd, 512, 0);
    if (per_cu < 1) per_cu = 1;
    if (per_cu > 1) per_cu = 1;
    grid_blocks = cus * per_cu;
  }
  hipMemsetAsync(p.bar, 0, (size_t)XCD_BAR_WORDS * 4 + 256, stream);
  int lo = 0, hi = NPHASE;
  void* args[] = {&p, &lo, &hi};
  hipError_t e = hipLaunchCooperativeKernel((void*)mk_fwd, dim3(grid_blocks), dim3(512), args, 0, stream);
  if (e != hipSuccess) fprintf(stderr, "cooperative launch failed: %s (grid %d)\n", hipGetErrorString(e), grid_blocks);
}
```
